# Optimizing an MI355X kernel written in HIP

```python
import math
import jax, jax.numpy as jnp
from jax import lax
import numpy as np

D_MODEL = 1024
BATCH = 4
SEQ = 4096
DEPTH = 4

N_MIXERS = 2
N_ATTN_LAYERS = (DEPTH + 1) // 2
N_POOL_LAYERS = DEPTH // 2
HEAD_DIM = 64
N_HEADS = D_MODEL // HEAD_DIM
N_KV_HEADS = 4
GROUP = N_HEADS // N_KV_HEADS
Q_WIDTH = N_HEADS * HEAD_DIM
KV_WIDTH = N_KV_HEADS * HEAD_DIM
ATTN_GATE_WIDTH = Q_WIDTH
ATTN_IN_WIDTH = Q_WIDTH + 2 * KV_WIDTH + ATTN_GATE_WIDTH
WINDOW = 128
BLOCK = 128
ROT_DIM = HEAD_DIM // 4
ROPE_THETA = 500000.0
POOL_WINDOWS = (2, 4, 8, 16)
N_POOL_GROUPS = len(POOL_WINDOWS)
POOL_WIDTH = D_MODEL
POOL_GROUP_DIM = POOL_WIDTH // N_POOL_GROUPS
POOL_IN_WIDTH = 2 * POOL_WIDTH
NORM_EPS = 1e-6

kernel_name = "hybrid_swa_sink_multiscale_pool_adaln"


def rms_norm(x, g):
    xf = x.astype(jnp.float32)
    y = xf * lax.rsqrt(jnp.mean(xf * xf, axis=-1, keepdims=True) + NORM_EPS)
    return (y * g.astype(jnp.float32)).astype(x.dtype)


def adaln_params(c, w, b):
    mod = jax.nn.silu(c) @ w + b
    shift, scale, gate = jnp.split(mod, 3, axis=-1)
    return shift[:, None, :], scale[:, None, :], gate[:, None, :]


def partial_rope(x, positions):
    half = ROT_DIM // 2
    inv_freq = ROPE_THETA ** (-jnp.arange(half, dtype=jnp.float32) * 2.0 / ROT_DIM)
    ang = positions.astype(jnp.float32)[..., None] * inv_freq
    cos = jnp.cos(ang)[:, :, None, :]
    sin = jnp.sin(ang)[:, :, None, :]
    xf = x.astype(jnp.float32)
    x1, x2 = xf[..., :half], xf[..., half:ROT_DIM]
    rot = jnp.concatenate([x1 * cos - x2 * sin, x2 * cos + x1 * sin], axis=-1)
    return jnp.concatenate([rot.astype(x.dtype), x[..., ROT_DIM:]], axis=-1)


def banded_sink_attention(q, k, v, sinks):
    B, S = q.shape[0], q.shape[1]
    nb = S // BLOCK
    qb = q.reshape(B, nb, BLOCK, N_KV_HEADS, GROUP, HEAD_DIM)

    def band(t):
        tp = jnp.pad(t, ((0, 0), (BLOCK, 0), (0, 0), (0, 0)))
        tb = tp.reshape(B, nb + 1, BLOCK, N_KV_HEADS, HEAD_DIM)
        return jnp.concatenate([tb[:, :-1], tb[:, 1:]], axis=2)

    kb, vb = band(k), band(v)
    scores = jnp.einsum('bnqkgd,bnskd->bnkgqs', qb, kb).astype(jnp.float32) * (HEAD_DIM ** -0.5)
    qi = jnp.arange(BLOCK)[:, None] + BLOCK
    ki = jnp.arange(2 * BLOCK)[None, :]
    diff = qi - ki
    band_ok = (diff >= 0) & (diff < WINDOW)
    key_abs = jnp.arange(nb)[:, None, None] * BLOCK + ki[None] - BLOCK
    mask = band_ok[None] & (key_abs >= 0)
    scores = jnp.where(mask[None, :, None, None], scores, -jnp.inf)
    sink = sinks.astype(jnp.float32).reshape(N_KV_HEADS, GROUP)[None, None, :, :, None, None]
    m = jnp.maximum(jnp.max(scores, axis=-1, keepdims=True), sink)
    p = jnp.exp(scores - m)
    denom = jnp.sum(p, axis=-1, keepdims=True) + jnp.exp(sink - m)
    probs = (p / denom).astype(v.dtype)
    o = jnp.einsum('bnkgqs,bnskd->bnqkgd', probs, vb)
    return o.reshape(B, S, N_HEADS * HEAD_DIM)


def attention_branch(h, positions, w_in, q_norm_g, k_norm_g, sinks, w_out):
    B, S = h.shape[0], h.shape[1]
    proj = h @ w_in
    q, k, v, g = jnp.split(proj, [Q_WIDTH, Q_WIDTH + KV_WIDTH, Q_WIDTH + 2 * KV_WIDTH], axis=-1)
    q = q.reshape(B, S, N_HEADS, HEAD_DIM)
    k = k.reshape(B, S, N_KV_HEADS, HEAD_DIM)
    v = v.reshape(B, S, N_KV_HEADS, HEAD_DIM)
    q = partial_rope(rms_norm(q, q_norm_g), positions)
    k = partial_rope(rms_norm(k, k_norm_g), positions)
    o = banded_sink_attention(q, k, v, sinks)
    return (o * jax.nn.silu(g)) @ w_out


def multiscale_pool(v):
    B, S = v.shape[0], v.shape[1]
    vf = v.astype(jnp.float32).reshape(B, S, N_POOL_GROUPS, POOL_GROUP_DIM)
    cs = jnp.concatenate([jnp.zeros((B, 1, N_POOL_GROUPS, POOL_GROUP_DIM), jnp.float32),
                          jnp.cumsum(vf, axis=1)], axis=1)
    t = jnp.arange(S)
    outs = []
    for gi, w in enumerate(POOL_WINDOWS):
        csg = cs[:, :, gi]
        upper = csg[:, 1:]
        lower = jnp.pad(csg[:, :S - w + 1], ((0, 0), (w - 1, 0), (0, 0)))
        count = jnp.minimum(t + 1, w).astype(jnp.float32)[None, :, None]
        outs.append((upper - lower) / count - vf[:, :, gi])
    return jnp.stack(outs, axis=2).astype(v.dtype)


def pool_branch(h, w_in, w_group, scale, w_out):
    B, S = h.shape[0], h.shape[1]
    proj = h @ w_in
    v, g = jnp.split(proj, [POOL_WIDTH], axis=-1)
    pooled = multiscale_pool(v)
    mixed = jnp.einsum('bsgc,gcd->bsgd', pooled, w_group).reshape(B, S, POOL_WIDTH)
    mixed = mixed * scale
    return (mixed * jax.nn.silu(g)) @ w_out


def setup_inputs(seed: int = 0) -> dict:
    key = jax.random.key(seed)
    ks = jax.random.split(key, 16)
    f32 = jnp.float32
    x = jax.random.normal(ks[0], (BATCH, SEQ, D_MODEL), f32)
    c = jax.random.normal(ks[1], (BATCH, D_MODEL), f32)
    offset = jax.random.randint(ks[2], (BATCH, 1), 0, 1024, dtype=jnp.int32)
    positions = offset + jnp.arange(SEQ, dtype=jnp.int32)[None, :]
    ada_w = jax.random.normal(ks[3], (DEPTH, D_MODEL, 3 * D_MODEL), f32) * (0.5 * D_MODEL ** -0.5)
    ada_b = jax.random.normal(ks[4], (DEPTH, 3 * D_MODEL), f32) * 0.02
    norm_g = 1.0 + 0.02 * jax.random.normal(ks[5], (DEPTH, D_MODEL), f32)
    attn_w_in = jax.random.normal(ks[6], (N_ATTN_LAYERS, D_MODEL, ATTN_IN_WIDTH), f32) * D_MODEL ** -0.5
    attn_q_norm = 1.0 + 0.02 * jax.random.normal(ks[7], (N_ATTN_LAYERS, HEAD_DIM), f32)
    attn_k_norm = 1.0 + 0.02 * jax.random.normal(ks[8], (N_ATTN_LAYERS, HEAD_DIM), f32)
    attn_sinks = 0.5 * jax.random.normal(ks[9], (N_ATTN_LAYERS, N_HEADS), f32)
    attn_w_out = jax.random.normal(ks[10], (N_ATTN_LAYERS, Q_WIDTH, D_MODEL), f32) * Q_WIDTH ** -0.5
    pool_w_in = jax.random.normal(ks[11], (N_POOL_LAYERS, D_MODEL, POOL_IN_WIDTH), f32) * D_MODEL ** -0.5
    pool_w_group = jax.random.normal(ks[12], (N_POOL_LAYERS, N_POOL_GROUPS, POOL_GROUP_DIM, POOL_GROUP_DIM), f32) * POOL_GROUP_DIM ** -0.5
    pool_scale = 1.0 + 0.1 * jax.random.normal(ks[13], (N_POOL_LAYERS, POOL_WIDTH), f32)
    pool_w_out = jax.random.normal(ks[14], (N_POOL_LAYERS, POOL_WIDTH, D_MODEL), f32) * POOL_WIDTH ** -0.5
    return {"x": x, "c": c, "positions": positions, "ada_w": ada_w, "ada_b": ada_b,
            "norm_g": norm_g, "attn_w_in": attn_w_in, "attn_q_norm": attn_q_norm,
            "attn_k_norm": attn_k_norm, "attn_sinks": attn_sinks, "attn_w_out": attn_w_out,
            "pool_w_in": pool_w_in, "pool_w_group": pool_w_group, "pool_scale": pool_scale,
            "pool_w_out": pool_w_out}


def reference(x, c, positions, ada_w, ada_b, norm_g, attn_w_in, attn_q_norm, attn_k_norm,
              attn_sinks, attn_w_out, pool_w_in, pool_w_group, pool_scale, pool_w_out):
    for i in range(DEPTH):
        shift, scale, gate = adaln_params(c, ada_w[i], ada_b[i])
        h = rms_norm(x, norm_g[i]) * (1.0 + scale) + shift
        j = i // N_MIXERS
        if i % N_MIXERS == 0:
            branch = attention_branch(h, positions, attn_w_in[j], attn_q_norm[j], attn_k_norm[j],
                                      attn_sinks[j], attn_w_out[j])
        else:
            branch = pool_branch(h, pool_w_in[j], pool_w_group[j], pool_scale[j], pool_w_out[j])
        x = x + gate * branch
    return x
```

```cpp
#include <hip/hip_runtime.h>
#include <hip/hip_bf16.h>
#include <cstdio>
#include <cstdint>

#ifndef MK_ONE_LAUNCH
#define MK_ONE_LAUNCH 1
#endif

namespace pg8 {
#define PG8_LAS __attribute__((address_space(3)))
typedef unsigned short bf16_t;
typedef short bf16x8 __attribute__((ext_vector_type(8)));
typedef float f32x4 __attribute__((ext_vector_type(4)));
typedef unsigned u32x4 __attribute__((ext_vector_type(4)));
typedef unsigned u32x2 __attribute__((ext_vector_type(2)));
constexpr int BM = 256, BK = 64, HALF = 128, HTB = HALF * BK * 2, STAGE_BYTES = 8 * HTB, NXCD = 8, WGM = 8;

__host__ __device__ __forceinline__ int lds_byte(int r, int c) { const int st = (r >> 4) * 2 + (c >> 5), rr = r & 15, cc = c & 31, ob = rr * 64 + cc * 2; return st * 1024 + (ob ^ (((ob >> 9) & 1) << 5)); }
__host__ __device__ __forceinline__ void stage_rc(int b, int& R, int& C) { const int st = b / 1024, sb = b % 1024, swz = sb ^ (((sb >> 9) & 1) << 5); R = (st >> 1) * 16 + swz / 64; C = (st & 1) * 32 + (swz % 64) / 2; }
__host__ __device__ __forceinline__ int perm32(int rho) { const int n = rho >> 4, i = rho & 15; return 8 * (i >> 2) + 4 * n + (i & 3); }

struct Unit { int pm, pn; };
struct Gemm { const bf16_t* A; const bf16_t* Bt; int M, N, K; int bsh; size_t bstr; };

struct StaticOrder {
    int nM, nN, nwg, G, c;
    __host__ __device__ void init(int M, int N, int G_, int c_) { nM = M / BM; nN = N / BM; nwg = nM * nN; G = G_; c = c_; }
    __host__ __device__ bool next(int i, Unit& u) const {
        const long L = (long)i * G + c; if (L >= nwg) return false;
        int wgid = (int)L; { const int q = nwg / NXCD, r = nwg % NXCD, xcd = wgid % NXCD, off = wgid / NXCD; wgid = (xcd < r ? xcd * (q + 1) : r * (q + 1) + (xcd - r) * q) + off; }
        const int nig = WGM * nN, gid = wgid / nig, fm = gid * WGM, gsz = (nM - fm) < WGM ? (nM - fm) : WGM;
        u.pm = fm + ((wgid % nig) % gsz); u.pn = (wgid % nig) / gsz; return true;
    }
    __device__ __forceinline__ void a_ready(const Unit&) const {}
    __device__ __forceinline__ void done(const Unit&) const {}
};

__device__ __forceinline__ unsigned cvt_pk_bf16(float lo, float hi) { unsigned r; asm volatile("v_cvt_pk_bf16_f32 %0, %1, %2" : "=v"(r) : "v"(lo), "v"(hi)); return r; }

template <class Epi, class Sched, bool ALIGN_EPI = false, bool SP2 = false>
__device__ __forceinline__ void gemm_phase(PG8_LAS unsigned char* lds, const Gemm g, const Sched& S, const Epi& E) {
    int tid_ = threadIdx.x; asm volatile("" : "+v"(tid_));
    const int tid = tid_, wid = __builtin_amdgcn_readfirstlane(tid >> 6), lane = tid & 63, wr = wid >> 2, wc = wid & 3, fr = lane & 15, fq = lane >> 4;
    const int K = g.K, nt = K / BK;
    unsigned voffA[2], voffB[2];
#pragma unroll
    for (int i = 0; i < 2; ++i) { int R, C; stage_rc(tid * 16 + i * 8192, R, C); const int Rb = Epi::PERM ? ((R & ~31) + perm32(R & 31)) : R;
        voffA[i] = (unsigned)(R * K + C) * 2u; voffB[i] = (unsigned)(Rb * K + C) * 2u; }
    const size_t kstep = (size_t)(BK * 2);
    const size_t hstep = (size_t)HALF * K * 2;
    const size_t tstep = 2 * hstep;
    const unsigned ldsw = (unsigned)wid * 1024u;
    const int aoff = lds_byte(wr * 64 + fr, fq * 8), boff = lds_byte(wc * 32 + fr, fq * 8);
#define PG8_SA(b, h) (((b) * 2 + (h)) * HTB)
#define PG8_SB(b, h) ((4 + (b) * 2 + (h)) * HTB)
#define PG8_STAGE(bufoff, gbase, voff) do { _Pragma("unroll") for (int _i = 0; _i < 2; ++_i) \
        __builtin_amdgcn_global_load_lds((const unsigned*)((const char*)(gbase) + (voff)[_i]), (PG8_LAS unsigned*)(lds + (bufoff) + ldsw + _i * 8192), 16, 0, 0); } while (0)
#define PG8_LDA(dst, b, h) do { _Pragma("unroll") for (int m = 0; m < 4; ++m) _Pragma("unroll") for (int k = 0; k < 2; ++k) dst[m][k] = *(const PG8_LAS bf16x8*)(lds + PG8_SA(b, h) + aoff + m * 2048 + k * 1024); } while (0)
#define PG8_LDB(dst, b, h) do { _Pragma("unroll") for (int n = 0; n < 2; ++n) _Pragma("unroll") for (int k = 0; k < 2; ++k) dst[n][k] = *(const PG8_LAS bf16x8*)(lds + PG8_SB(b, h) + boff + n * 2048 + k * 1024); } while (0)
#define PG8_MMA(ai, bj, At, Bt) do { __builtin_amdgcn_s_setprio(1); _Pragma("unroll") for (int m = 0; m < 4; ++m) _Pragma("unroll") for (int n = 0; n < 2; ++n) _Pragma("unroll") for (int k = 0; k < 2; ++k) \
        acc[ai][bj][m][n] = __builtin_amdgcn_mfma_f32_16x16x32_bf16(Bt[n][k], At[m][k], acc[ai][bj][m][n], 0, 0, 0); __builtin_amdgcn_s_setprio(0); } while (0)
#define PG8_WAIT_V(n) asm volatile("s_waitcnt vmcnt(" #n ")" ::: "memory")
#define PG8_WAIT_L(n) asm volatile("s_waitcnt lgkmcnt(" #n ")" ::: "memory")
#define PG8_BAR __builtin_amdgcn_s_barrier()
#define PG8_SCHED __builtin_amdgcn_sched_barrier(0)
    Unit cur, nxt; int ui = 0;
    if (!S.next(0, cur)) return;
    f32x4 acc[2][2][4][2];
#pragma unroll
    for (int a = 0; a < 2; ++a)
#pragma unroll
        for (int b = 0; b < 2; ++b)
#pragma unroll
            for (int m = 0; m < 4; ++m)
#pragma unroll
                for (int n = 0; n < 2; ++n) acc[a][b][m][n] = (f32x4){0.f, 0.f, 0.f, 0.f};
    bf16x8 At[4][2], B0[2][2], B1[2][2];
    const char* cA = (const char*)g.A + (size_t)cur.pm * tstep; const char* cB = (const char*)g.Bt + (size_t)(cur.pm >> g.bsh) * g.bstr + (size_t)cur.pn * tstep;
    S.a_ready(cur);
    if constexpr (SP2) {
        PG8_STAGE(PG8_SB(0, 0), cB, voffB); PG8_STAGE(PG8_SB(0, 1), cB + hstep, voffB); PG8_STAGE(PG8_SA(0, 0), cA, voffA); PG8_STAGE(PG8_SA(0, 1), cA + hstep, voffA);
        if (wr == 1) PG8_BAR;
        PG8_WAIT_V(2); PG8_BAR;
        PG8_STAGE(PG8_SB(1, 0), cB + kstep, voffB); PG8_STAGE(PG8_SA(1, 0), cA + kstep, voffA); PG8_STAGE(PG8_SB(1, 1), cB + hstep + kstep, voffB);
        PG8_WAIT_V(6); PG8_BAR;
    } else {
        PG8_STAGE(PG8_SB(0, 0), cB, voffB); PG8_STAGE(PG8_SA(0, 0), cA, voffA); PG8_STAGE(PG8_SB(0, 1), cB + hstep, voffB); PG8_STAGE(PG8_SA(0, 1), cA + hstep, voffA);
        if (wr == 1) PG8_BAR;
        PG8_WAIT_V(4); PG8_BAR;
        PG8_STAGE(PG8_SB(1, 0), cB + kstep, voffB); PG8_STAGE(PG8_SA(1, 0), cA + kstep, voffA); PG8_STAGE(PG8_SB(1, 1), cB + hstep + kstep, voffB);
        PG8_WAIT_V(6); PG8_BAR;
    }
    for (;;) {
        const bool has_next = S.next(ui + 1, nxt);
        const char* nA = has_next ? (const char*)g.A + (size_t)nxt.pm * tstep : cA; const char* nB = has_next ? (const char*)g.Bt + (size_t)(nxt.pm >> g.bsh) * g.bstr + (size_t)nxt.pn * tstep : cB;
        for (int t = 0; t < nt; t += 2) {
            const bool last = (t == nt - 2);
            const char* a1 = cA + (size_t)(t + 1) * kstep;
            const char* a2 = last ? nA : cA + (size_t)(t + 2) * kstep; const char* b2 = last ? nB : cB + (size_t)(t + 2) * kstep;
            const char* a3 = a2 + kstep; const char* b3 = b2 + kstep;
            if (last && has_next) S.a_ready(nxt);
            if constexpr (SP2) {
            PG8_LDB(B0, 0, 0); PG8_LDB(B1, 0, 1); PG8_SCHED; PG8_LDA(At, 0, 0); PG8_STAGE(PG8_SA(1, 1), a1 + hstep, voffA);
            PG8_WAIT_V(8); PG8_WAIT_L(0); PG8_BAR; PG8_MMA(0, 0, At, B0); PG8_MMA(0, 1, At, B1); PG8_BAR; PG8_SCHED;
            PG8_LDA(At, 0, 1); PG8_STAGE(PG8_SB(0, 0), b2, voffB); PG8_STAGE(PG8_SB(0, 1), b2 + hstep, voffB); PG8_STAGE(PG8_SA(0, 0), a2, voffA);
            PG8_WAIT_V(8); PG8_WAIT_L(0); PG8_BAR; PG8_MMA(1, 0, At, B0); PG8_MMA(1, 1, At, B1); PG8_BAR; PG8_SCHED;
            PG8_LDB(B0, 1, 0); PG8_LDB(B1, 1, 1); PG8_SCHED; PG8_LDA(At, 1, 0); PG8_STAGE(PG8_SA(0, 1), a2 + hstep, voffA);
            PG8_WAIT_V(8); PG8_WAIT_L(0); PG8_BAR; PG8_MMA(0, 0, At, B0); PG8_MMA(0, 1, At, B1); PG8_BAR; PG8_SCHED;
            PG8_LDA(At, 1, 1); PG8_STAGE(PG8_SB(1, 0), b3, voffB); PG8_STAGE(PG8_SB(1, 1), b3 + hstep, voffB); PG8_STAGE(PG8_SA(1, 0), a3, voffA);
            PG8_WAIT_V(8); PG8_WAIT_L(0); PG8_BAR; PG8_MMA(1, 0, At, B0); PG8_MMA(1, 1, At, B1); PG8_BAR; PG8_SCHED;
            } else {
            PG8_LDB(B0, 0, 0); PG8_SCHED; PG8_LDA(At, 0, 0); PG8_STAGE(PG8_SA(1, 1), a1 + hstep, voffA);
            PG8_WAIT_L(8); PG8_BAR; PG8_WAIT_L(0); PG8_MMA(0, 0, At, B0); PG8_BAR; PG8_SCHED;
            PG8_LDB(B1, 0, 1); PG8_STAGE(PG8_SB(0, 0), b2, voffB);
            PG8_BAR; PG8_WAIT_L(0); PG8_MMA(0, 1, At, B1); PG8_BAR;
            PG8_LDA(At, 0, 1); PG8_STAGE(PG8_SA(0, 0), a2, voffA);
            PG8_BAR; PG8_WAIT_L(0); PG8_MMA(1, 0, At, B0); PG8_BAR; PG8_SCHED;
            PG8_STAGE(PG8_SB(0, 1), b2 + hstep, voffB);
            PG8_WAIT_V(6); PG8_BAR; PG8_MMA(1, 1, At, B1); PG8_BAR;
            PG8_LDB(B0, 1, 0); PG8_SCHED; PG8_LDA(At, 1, 0); PG8_STAGE(PG8_SA(0, 1), a2 + hstep, voffA);
            PG8_WAIT_L(8); PG8_BAR; PG8_WAIT_L(0); PG8_MMA(0, 0, At, B0); PG8_BAR; PG8_SCHED;
            PG8_LDB(B1, 1, 1); PG8_STAGE(PG8_SB(1, 0), b3, voffB);
            PG8_BAR; PG8_WAIT_L(0); PG8_MMA(0, 1, At, B1); PG8_BAR;
            PG8_LDA(At, 1, 1); PG8_STAGE(PG8_SA(1, 0), a3, voffA);
            PG8_BAR; PG8_WAIT_L(0); PG8_MMA(1, 0, At, B0); PG8_BAR; PG8_SCHED;
            PG8_STAGE(PG8_SB(1, 1), b3 + hstep, voffB);
            PG8_WAIT_V(6); PG8_BAR; PG8_MMA(1, 1, At, B1); PG8_BAR;
            }
        }
        if constexpr (ALIGN_EPI) { if (wr == 0) PG8_BAR; }
        if constexpr (!Epi::AFTER_DRAIN) { E(acc, cur, wr, wc, fr, fq); S.done(cur); }
        if (!has_next) break;
#pragma unroll
        for (int a = 0; a < 2; ++a)
#pragma unroll
            for (int b = 0; b < 2; ++b)
#pragma unroll
                for (int m = 0; m < 4; ++m)
#pragma unroll
                    for (int n = 0; n < 2; ++n) acc[a][b][m][n] = (f32x4){0.f, 0.f, 0.f, 0.f};
        cur = nxt; cA = nA; cB = nB; ++ui;
        if constexpr (ALIGN_EPI) { if (wr == 1) PG8_BAR; }
    }
    PG8_WAIT_V(0);
    if constexpr (!ALIGN_EPI) { if (wr == 0) PG8_BAR; }
    PG8_BAR;
    if constexpr (Epi::AFTER_DRAIN) { E.fused(acc, cur, wr, wc, fr, fq, lds, wid, lane); S.done(cur); }
#undef PG8_SA
#undef PG8_SB
#undef PG8_STAGE
#undef PG8_LDA
#undef PG8_LDB
#undef PG8_MMA
#undef PG8_WAIT_V
#undef PG8_WAIT_L
#undef PG8_BAR
#undef PG8_SCHED
}
}

constexpr int BATCH = 4, SEQ = 4096, DM = 1024, M = BATCH * SEQ, DEPTH = 4;
constexpr int NAIN = 2560, NPIN = 2048, MODW = 3072;
constexpr float NORM_EPS = 1e-6f, LOG2E = 1.4426950408889634f, C2 = 0.125f * 1.4426950408889634f;
constexpr int NWAVES = 8;

constexpr size_t MiB = 1u << 20, KiB = 1024;
constexpr size_t WS_CTL = 0, CTL_ZERO_BYTES = 1 * MiB;
constexpr size_t WS_MOD = 1 * MiB;
constexpr size_t WS_SBA = 1 * MiB + 256 * KiB;
constexpr size_t WS_SBP = 1 * MiB + 384 * KiB;
constexpr size_t WS_ROWSS = 1 * MiB + 512 * KiB;
constexpr size_t WS_ROPE = 2 * MiB;
constexpr size_t WS_WAIN = 4 * MiB;
constexpr size_t WS_WPIN = 14 * MiB;
constexpr size_t WS_WAOUT = 22 * MiB;
constexpr size_t WS_WPOUT = 26 * MiB;
constexpr size_t WS_CA = 30 * MiB;
constexpr size_t WS_CB = 31 * MiB;
constexpr size_t WS_XB = 36 * MiB;
constexpr size_t WS_Q = 68 * MiB;
constexpr size_t WS_SG = 100 * MiB;
constexpr size_t WS_K = 132 * MiB;
constexpr size_t WS_V = 140 * MiB;
constexpr size_t WS_END = 148 * MiB;
constexpr int CW_BAR = 4096;

constexpr int RING_BYTES = 131072;
constexpr int LDSCTL_OFF = 135168, LDS_BYTES = 139264;

#define GAS __attribute__((address_space(1)))
#define LAS __attribute__((address_space(3)))
typedef unsigned short bf16;
typedef unsigned v4u __attribute__((ext_vector_type(4)));
typedef unsigned v2u __attribute__((ext_vector_type(2)));
typedef float f32x4 __attribute__((ext_vector_type(4)));
typedef float f32x16 __attribute__((ext_vector_type(16)));
typedef short bf16x8 __attribute__((ext_vector_type(8)));
typedef short s16x4 __attribute__((ext_vector_type(4)));
typedef GAS unsigned gu32;
#define RLX_AGENT __ATOMIC_RELAXED, __HIP_MEMORY_SCOPE_AGENT
#define LDS_WAIT() asm volatile("s_waitcnt lgkmcnt(0)" ::: "memory")
#define VM_WAIT() asm volatile("s_waitcnt vmcnt(0)" ::: "memory")
__device__ __forceinline__ unsigned f2bf(float f) { unsigned u = __builtin_bit_cast(unsigned, f); return (u + 0x7fffu + ((u >> 16) & 1u)) >> 16; }
__device__ __forceinline__ unsigned pk2(float lo, float hi) { return f2bf(lo) | (f2bf(hi) << 16); }
__device__ __forceinline__ float bf_lo(unsigned w) { return __builtin_bit_cast(float, w << 16); }
__device__ __forceinline__ float bf_hi(unsigned w) { return __builtin_bit_cast(float, w & 0xffff0000u); }
__device__ __forceinline__ float silu_f(float v) { return v * __builtin_amdgcn_rcpf(1.0f + __builtin_amdgcn_exp2f(-v * LOG2E)); }

#define XB_TMO      128
#define XB_XCNT(j)  (256  + 64 * (j))
#define XB_XSUB(j)  (1280 + 64 * (j))
#define XB_XGEN(j)  (2304 + 64 * (j))
#define XB_TOP      3328
#define XB_TOPGEN   3392
#define XCD_BAR_WORDS 3456
#define XB_SPIN_CAP (1u << 18)
__device__ __forceinline__ unsigned xb_ld(unsigned* p)              { return __hip_atomic_load(p, __ATOMIC_RELAXED, __HIP_MEMORY_SCOPE_AGENT); }
__device__ __forceinline__ unsigned xb_add(unsigned* p, unsigned v) { return __hip_atomic_fetch_add(p, v, __ATOMIC_RELAXED, __HIP_MEMORY_SCOPE_AGENT); }
__device__ __forceinline__ unsigned xb_xcc_id() { return (unsigned)__builtin_amdgcn_s_getreg((3 << 11) | 20) & 0xFu; }
#define XB_SPIN(cond, bar) do { unsigned _sp = 0; while (cond) { __builtin_amdgcn_s_sleep(1); \
    if ((++_sp & 255u) == 0u) { if (xb_ld(&(bar)[XB_TMO])) break; if (_sp > XB_SPIN_CAP) { atomicAdd(&(bar)[XB_TMO], 1u); break; } } } } while (0)
struct XcdBarrier { unsigned* bar; unsigned x; volatile LAS unsigned* st; };
__device__ __forceinline__ XcdBarrier xcd_barrier_post(unsigned* bar, volatile LAS unsigned* st) {
    XcdBarrier b; b.bar = bar; b.x = xb_xcc_id(); b.st = st;
    if (threadIdx.x == 0) (void)xb_add(&bar[XB_XCNT(b.x)], 1u);
    return b;
}
__device__ __forceinline__ void xcd_barrier_complete(unsigned* bar, unsigned x, unsigned& nloc, unsigned& nx) {
    const unsigned G = gridDim.x * gridDim.y * gridDim.z;
    unsigned sum, cnt, mine, sp = 0u;
    for (;;) {
        sum = 0u; cnt = 0u; mine = 0u;
#pragma unroll
        for (unsigned j = 0; j < 16; ++j) { const unsigned c = xb_ld(&bar[XB_XCNT(j)]); sum += c; cnt += (c > 0u) ? 1u : 0u; mine = (j == x) ? c : mine; }
        if (sum == G) break;
        __builtin_amdgcn_s_sleep(1);
        if ((++sp & 255u) == 0u) { if (xb_ld(&bar[XB_TMO])) break; if (sp > XB_SPIN_CAP) { atomicAdd(&bar[XB_TMO], 1u); break; } }
    }
    nloc = mine > 0u ? mine : 1u; nx = cnt > 0u ? cnt : 1u;
}
__device__ __forceinline__ void xcd_barrier(const XcdBarrier& b) {
    asm volatile("s_waitcnt vmcnt(0)" ::: "memory");
    __syncthreads();
    if (threadIdx.x == 0) {
        unsigned* bar = b.bar;
        __builtin_amdgcn_s_waitcnt(0);
        unsigned nloc = b.st[0], nx = b.st[1];
        if (nloc == 0u) { xcd_barrier_complete(bar, b.x, nloc, nx); b.st[0] = nloc; b.st[1] = nx; }
        const unsigned old = xb_add(&bar[XB_XSUB(b.x)], 1u);
        const unsigned gen = old / nloc;
        if (old + 1u == (gen + 1u) * nloc) {
            __builtin_amdgcn_fence(__ATOMIC_RELEASE, "agent");
            asm volatile("s_waitcnt vmcnt(0)" ::: "memory");
            const unsigned og = xb_add(&bar[XB_TOP], 1u);
            const unsigned tg = og / nx;
            if (og + 1u == (tg + 1u) * nx) xb_add(&bar[XB_TOPGEN], 1u);
            else XB_SPIN(xb_ld(&bar[XB_TOPGEN]) == tg, bar);
            __builtin_amdgcn_fence(__ATOMIC_ACQUIRE, "agent");
            xb_add(&bar[XB_XGEN(b.x)], 1u);
            asm volatile("s_waitcnt vmcnt(0)" ::: "memory");
        } else {
            XB_SPIN(xb_ld(&bar[XB_XGEN(b.x)]) == gen, bar);
            __builtin_amdgcn_fence(__ATOMIC_ACQUIRE, "agent");
            asm volatile("s_waitcnt vmcnt(0)" ::: "memory");
        }
    }
    __syncthreads();
}

namespace pg8 {
__device__ __forceinline__ float row_rstd(const float* rowss, int row) {
    const float s = (rowss[row] + rowss[M + row]) + (rowss[2 * M + row] + rowss[3 * M + row]);
    return __builtin_amdgcn_rsqf(s * (1.0f / DM) + NORM_EPS);
}
__device__ __forceinline__ u32x4 pack8(const f32x4 a, const f32x4 b) { u32x4 w; w.x = cvt_pk_bf16(a[0], a[1]); w.y = cvt_pk_bf16(a[2], a[3]); w.z = cvt_pk_bf16(b[0], b[1]); w.w = cvt_pk_bf16(b[2], b[3]); return w; }

struct EpiAttnIn {
    static constexpr bool PERM = true, AFTER_DRAIN = false;
    const float* rowss; const float* sb; const float* qg; const float* kg; const float* rcos; const float* rsin; bf16_t *Q, *K, *V, *SG;
    __device__ __forceinline__ void operator()(const f32x4 (&acc)[2][2][4][2], const Unit& u, int wr, int wc, int fr, int fq) const {
        const int b = u.pm >> 4, pn = u.pn;
        const bool qk = pn < 5;
        int dl[2][2];
#pragma unroll
        for (int bj = 0; bj < 2; ++bj)
#pragma unroll
            for (int n = 0; n < 2; ++n) dl[bj][n] = (qk && bj == 0 && fq < 2) ? (4 * fq + 8 * n) : (32 * bj + 8 * fq + 4 * n);
        const float* sbp = sb + b * NAIN + pn * 256 + 64 * wc;
        f32x4 sbv[2][2];
#pragma unroll
        for (int bj = 0; bj < 2; ++bj)
#pragma unroll
            for (int n = 0; n < 2; ++n) sbv[bj][n] = *(const f32x4*)(sbp + dl[bj][n]);
        const int row0 = u.pm * BM + wr * 64 + fr;
        if (qk) {
            const float* gp = (pn < 4) ? qg : kg;
            f32x4 gv[2][2];
#pragma unroll
            for (int bj = 0; bj < 2; ++bj)
#pragma unroll
                for (int n = 0; n < 2; ++n) gv[bj][n] = *(const f32x4*)(gp + dl[bj][n]);
            const float osc = (pn < 4) ? C2 : 1.0f;
            bf16_t* obase = (pn < 4) ? (Q + pn * 256 + 64 * wc + 8 * fq) : (K + 64 * wc + 8 * fq);
            const int ld = (pn < 4) ? DM : 256;
#pragma unroll
            for (int ai = 0; ai < 2; ++ai)
#pragma unroll
                for (int m = 0; m < 4; ++m) {
                    const int row = row0 + ai * HALF + m * 16;
                    const float rs = row_rstd(rowss, row);
                    const f32x4 cs = *(const f32x4*)(rcos + (size_t)row * 8 + 4 * (fq & 1)), sn = *(const f32x4*)(rsin + (size_t)row * 8 + 4 * (fq & 1));
                    f32x4 v[2][2]; float ss = 0.f;
#pragma unroll
                    for (int bj = 0; bj < 2; ++bj)
#pragma unroll
                        for (int n = 0; n < 2; ++n) { v[bj][n] = acc[ai][bj][m][n] * rs + sbv[bj][n]; const f32x4 t = v[bj][n] * v[bj][n]; ss += (t[0] + t[1]) + (t[2] + t[3]); }
                    ss += __shfl_xor(ss, 16); ss += __shfl_xor(ss, 32);
                    const float rq = __builtin_amdgcn_rsqf(ss * (1.0f / 64.0f) + NORM_EPS);
#pragma unroll
                    for (int bj = 0; bj < 2; ++bj)
#pragma unroll
                        for (int n = 0; n < 2; ++n) v[bj][n] = v[bj][n] * rq * gv[bj][n];
                    if (fq < 2) { const f32x4 x1 = v[0][0], x2 = v[0][1]; v[0][0] = x1 * cs - x2 * sn; v[0][1] = x2 * cs + x1 * sn; }
#pragma unroll
                    for (int bj = 0; bj < 2; ++bj) *(u32x4*)(obase + (size_t)row * ld + 32 * bj) = pack8(v[bj][0] * osc, v[bj][1] * osc);
                    asm volatile("" ::: "memory");
                }
        } else if (pn == 5) {
            bf16_t* obase = V + 64 * wc + 8 * fq;
#pragma unroll
            for (int ai = 0; ai < 2; ++ai)
#pragma unroll
                for (int m = 0; m < 4; ++m) {
                    const int row = row0 + ai * HALF + m * 16;
                    const float rs = row_rstd(rowss, row);
#pragma unroll
                    for (int bj = 0; bj < 2; ++bj) *(u32x4*)(obase + (size_t)row * 256 + 32 * bj) = pack8(acc[ai][bj][m][0] * rs + sbv[bj][0], acc[ai][bj][m][1] * rs + sbv[bj][1]);
                    asm volatile("" ::: "memory");
                }
        } else {
            bf16_t* obase = SG + (pn - 6) * 256 + 64 * wc + 8 * fq;
#pragma unroll
            for (int ai = 0; ai < 2; ++ai)
#pragma unroll
                for (int m = 0; m < 4; ++m) {
                    const int row = row0 + ai * HALF + m * 16;
                    const float rs = row_rstd(rowss, row);
#pragma unroll
                    for (int bj = 0; bj < 2; ++bj) { f32x4 a = acc[ai][bj][m][0] * rs + sbv[bj][0], c = acc[ai][bj][m][1] * rs + sbv[bj][1];
#pragma unroll
                        for (int e = 0; e < 4; ++e) { a[e] = silu_f(a[e]); c[e] = silu_f(c[e]); }
                        *(u32x4*)(obase + (size_t)row * DM + 32 * bj) = pack8(a, c); }
                    asm volatile("" ::: "memory");
                }
        }
    }
};

struct EpiPoolIn {
    static constexpr bool PERM = true, AFTER_DRAIN = false;
    const float* rowss; const float* sb; bf16_t *U, *SG;
    __device__ __forceinline__ void operator()(const f32x4 (&acc)[2][2][4][2], const Unit& u, int wr, int wc, int fr, int fq) const {
        const int b = u.pm >> 4, pn = u.pn;
        const int row0 = u.pm * BM + wr * 64 + fr, colw = wc * 32 + 8 * fq;
        if (pn < 4) {
            bf16_t* obase = U + pn * 256 + colw;
#pragma unroll
            for (int ai = 0; ai < 2; ++ai)
#pragma unroll
                for (int m = 0; m < 4; ++m) {
                    const int row = row0 + ai * HALF + m * 16;
                    const float rs = row_rstd(rowss, row);
#pragma unroll
                    for (int bj = 0; bj < 2; ++bj) *(u32x4*)(obase + (size_t)row * DM + bj * HALF) = pack8(acc[ai][bj][m][0] * rs, acc[ai][bj][m][1] * rs);
                    asm volatile("" ::: "memory");
                }
        } else {
            const float* sbp = sb + b * DM + (pn - 4) * 256 + colw;
            f32x4 sbv[2][2];
#pragma unroll
            for (int bj = 0; bj < 2; ++bj)
#pragma unroll
                for (int n = 0; n < 2; ++n) sbv[bj][n] = *(const f32x4*)(sbp + bj * HALF + 4 * n);
            bf16_t* obase = SG + (pn - 4) * 256 + colw;
#pragma unroll
            for (int ai = 0; ai < 2; ++ai)
#pragma unroll
                for (int m = 0; m < 4; ++m) {
                    const int row = row0 + ai * HALF + m * 16;
                    const float rs = row_rstd(rowss, row);
#pragma unroll
                    for (int bj = 0; bj < 2; ++bj) { f32x4 a = acc[ai][bj][m][0] * rs + sbv[bj][0], c = acc[ai][bj][m][1] * rs + sbv[bj][1];
#pragma unroll
                        for (int e = 0; e < 4; ++e) { a[e] = silu_f(a[e]); c[e] = silu_f(c[e]); }
                        *(u32x4*)(obase + (size_t)row * DM + bj * HALF) = pack8(a, c); }
                    asm volatile("" ::: "memory");
                }
        }
    }
};

struct EpiComb {
    static constexpr bool PERM = true, AFTER_DRAIN = false;
    bf16_t* O;
    __device__ __forceinline__ void operator()(const f32x4 (&acc)[2][2][4][2], const Unit& u, int wr, int wc, int fr, int fq) const {
        const int rowt = (u.pm >> 2) * NPIN + (u.pm & 3) * 256 + wr * 64 + fr, col0 = u.pn * BM + wc * 32 + 8 * fq;
#pragma unroll
        for (int ai = 0; ai < 2; ++ai)
#pragma unroll
            for (int m = 0; m < 4; ++m) { bf16_t* rowp = O + (size_t)(rowt + ai * HALF + m * 16) * DM + col0;
#pragma unroll
                for (int bj = 0; bj < 2; ++bj) *(u32x4*)(rowp + bj * HALF) = pack8(acc[ai][bj][m][0], acc[ai][bj][m][1]); }
    }
};

struct EpiOut {
    static constexpr bool PERM = false, AFTER_DRAIN = true;
    const float* xin; float* xout; const float* gate;   const float* ng_next; const float* scale_next; bf16_t* xb; float* rowss;
    __device__ __forceinline__ void fused(f32x4 (&acc)[2][2][4][2], const Unit& u, int wr, int wc, int fr, int fq, PG8_LAS unsigned char* lds, int wid, int lane) const {
        const int b = u.pm >> 4;
        const int col0 = u.pn * BM + wc * 32 + 4 * fq;
        const bool nxt = (xb != nullptr);
        f32x4 gt[2][2], fd[2][2];
#pragma unroll
        for (int bj = 0; bj < 2; ++bj)
#pragma unroll
            for (int n = 0; n < 2; ++n) { const int c = col0 + bj * HALF + n * 16;
                gt[bj][n] = *(const f32x4*)(gate + b * MODW + c);
                if (nxt) { const f32x4 g = *(const f32x4*)(ng_next + c), s = *(const f32x4*)(scale_next + b * MODW + c); fd[bj][n] = g * (s + 1.0f); } else fd[bj][n] = (f32x4){0.f, 0.f, 0.f, 0.f}; }
        PG8_LAS float* P = (PG8_LAS float*)lds;
#pragma unroll
        for (int ai = 0; ai < 2; ++ai)
#pragma unroll
            for (int m = 0; m < 4; ++m) {
                const int rt = ai * HALF + wr * 64 + m * 16 + fr; const size_t off = (size_t)(u.pm * BM + rt) * DM + col0;
                float ss = 0.f;
#pragma unroll
                for (int bj = 0; bj < 2; ++bj)
#pragma unroll
                    for (int n = 0; n < 2; ++n) { const f32x4 xo = *(const f32x4*)(xin + off + bj * HALF + n * 16); const f32x4 xn = xo + gt[bj][n] * acc[ai][bj][m][n];
                        *(f32x4*)(xout + off + bj * HALF + n * 16) = xn; const f32x4 t = xn * xn; ss += (t[0] + t[1]) + (t[2] + t[3]);
                        if (nxt) { const f32x4 y = xn * fd[bj][n]; u32x2 w; w.x = cvt_pk_bf16(y[0], y[1]); w.y = cvt_pk_bf16(y[2], y[3]); *(u32x2*)(xb + off + bj * HALF + n * 16) = w; } }
                ss += __shfl_xor(ss, 16); ss += __shfl_xor(ss, 32);
                if (nxt && fq == 0) P[rt * 4 + wc] = ss;
                asm volatile("" ::: "memory");
            }
        if (nxt) {
            asm volatile("s_waitcnt lgkmcnt(0)" ::: "memory"); __builtin_amdgcn_s_barrier(); asm volatile("" ::: "memory");
            const int t = wid * 64 + lane;
            if (t < 256) { const float s = (P[t * 4 + 0] + P[t * 4 + 1]) + (P[t * 4 + 2] + P[t * 4 + 3]); rowss[(size_t)u.pn * M + u.pm * BM + t] = s; }
            asm volatile("s_waitcnt lgkmcnt(0)" ::: "memory"); __builtin_amdgcn_s_barrier(); asm volatile("" ::: "memory");
        }
    }
};
}

namespace att {
typedef LAS const char* lds_cptr;
typedef LAS char* lds_ptr;
typedef short v4i16_t __attribute__((ext_vector_type(4)));
constexpr int KOFF = 0, VOFF = 49152, UBYTES = 24576, WSFOFF = 98304, OSTOFF = 100352;
__device__ __forceinline__ void glds16(const void* gsrc, unsigned lds_dst) { unsigned keep;
    asm volatile("s_mov_b32 %0, m0\n\ts_mov_b32 m0, %2\n\ts_nop 0\n\tglobal_load_lds_dwordx4 %1, off\n\ts_mov_b32 m0, %0" : "=&s"(keep) : "v"(gsrc), "s"(lds_dst) : "memory"); }
__device__ __forceinline__ s16x4 vtr(lds_cptr p) { return __builtin_bit_cast(s16x4, __builtin_amdgcn_ds_read_tr16_b64_v4i16((LAS v4i16_t*)p)); }
__device__ __forceinline__ unsigned cvtpk(float lo, float hi) { unsigned r; asm("v_cvt_pk_bf16_f32 %0, %1, %2" : "=v"(r) : "v"(lo), "v"(hi)); return r; }

__device__ __forceinline__ void dma_unit(const bf16* Kb, const bf16* Vb, int uid, int buf, unsigned lds0, int wid, int lane) {
    const int b = uid >> 8, kvh = (uid >> 6) & 3, qb = uid & 63, q0 = qb * 64; const long rowbase = (long)b * SEQ;
#pragma unroll
    for (int t = 0; t < 3; ++t) { int key = q0 - 128 + 64 * t + lane; key = key < 0 ? 0 : key;
        glds16(Kb + (rowbase + key) * 256 + kvh * 64 + wid * 8, (unsigned)__builtin_amdgcn_readfirstlane(lds0 + KOFF + buf * UBYTES + t * 8192 + wid * 1024)); }
#pragma unroll
    for (int t = 0; t < 3; ++t) { int key = q0 - 128 + 64 * t + 16 * (wid & 3) + (lane >> 2); key = key < 0 ? 0 : key;
        glds16(Vb + (rowbase + key) * 256 + kvh * 64 + (wid >> 2) * 32 + (lane & 3) * 8, (unsigned)__builtin_amdgcn_readfirstlane(lds0 + VOFF + buf * UBYTES + t * 8192 + wid * 1024)); }
}

__device__ __forceinline__ void attn_phase(LAS unsigned char* ldsb, const bf16* Qb, const bf16* Kb, const bf16* Vb, const bf16* SGb, bf16* OGb, const float* sinks, int vcu, int G) {
    int tid_ = threadIdx.x; asm volatile("" : "+v"(tid_));
    const int tid = tid_, lane = tid & 63, r32 = lane & 31, hi = lane >> 5; const int wid = __builtin_amdgcn_readfirstlane(tid >> 6);
    const int j = wid & 1, hq = wid >> 1;
    const unsigned lds0 = (unsigned)(uintptr_t)ldsb;
    LAS float* wsf = (LAS float*)(ldsb + WSFOFF) + wid * 64;
    LAS bf16* stg = (LAS bf16*)(ldsb + OSTOFF) + wid * 2048;
    const int nunits = BATCH * 4 * (SEQ / 64);
    const int per = nunits / G;
    const int uid0 = vcu * per;
    bf16x8 qn[4];
    {   const int uid = uid0; const int b = uid >> 8, kvh = (uid >> 6) & 3, qb = uid & 63; const bf16* Qw = Qb + ((long)b * SEQ + qb * 64 + 32 * j + r32) * DM + (kvh * 4 + hq) * 64;
#pragma unroll
        for (int d0 = 0; d0 < 4; ++d0) qn[d0] = *(const bf16x8*)(Qw + d0 * 16 + hi * 8);
        dma_unit(Kb, Vb, uid, 0, lds0, wid, lane); }
    for (int i = 0; i < per; ++i) {
        const int uid = uid0 + i, buf = i & 1;
        const int b = uid >> 8, kvh = (uid >> 6) & 3, qb = uid & 63, q0 = qb * 64, h = kvh * 4 + hq; const long rowbase = (long)b * SEQ;
        bf16x8 qr[4];
        asm volatile("s_waitcnt vmcnt(0)" : "+v"(qn[0]), "+v"(qn[1]), "+v"(qn[2]), "+v"(qn[3]) :: "memory");
#pragma unroll
        for (int d0 = 0; d0 < 4; ++d0) qr[d0] = qn[d0];
        asm volatile("s_waitcnt lgkmcnt(0)\n\ts_barrier" ::: "memory");
        if (i + 1 < per) {
            const int u2 = uid + 1; dma_unit(Kb, Vb, u2, buf ^ 1, lds0, wid, lane);
            const int b2 = u2 >> 8, kvh2 = (u2 >> 6) & 3, qb2 = u2 & 63; const bf16* Qw = Qb + ((long)b2 * SEQ + qb2 * 64 + 32 * j + r32) * DM + (kvh2 * 4 + hq) * 64;
#pragma unroll
            for (int d0 = 0; d0 < 4; ++d0) qn[d0] = *(const bf16x8*)(Qw + d0 * 16 + hi * 8);
        }
        const lds_cptr kp = (lds_cptr)ldsb + KOFF + buf * UBYTES + hi * 1024 + r32 * 16;
        f32x16 S[5];
#pragma unroll
        for (int ii = 0; ii < 5; ++ii) { const int kb = j + ii; const lds_cptr p = kp + (kb >> 1) * 8192 + (kb & 1) * 512;
            f32x16 a = f32x16{};
#pragma unroll
            for (int d0 = 0; d0 < 4; ++d0) { const bf16x8 kf = *(const LAS bf16x8*)(p + d0 * 2048); a = __builtin_amdgcn_mfma_f32_32x32x16_bf16(kf, qr[d0], a, 0, 0, 0); }
            S[ii] = a; }
        const float NEG = -INFINITY;
#pragma unroll
        for (int r = 0; r < 16; ++r) { const int c = (r & 3) + 8 * (r >> 2) + 4 * hi; if (!(c > r32)) S[0][r] = NEG; if (!(c <= r32)) S[4][r] = NEG; }
        if (q0 < 128) {
#pragma unroll
            for (int ii = 0; ii < 4; ++ii)
#pragma unroll
                for (int r = 0; r < 16; ++r) { const int c = (r & 3) + 8 * (r >> 2) + 4 * hi; if (q0 - 128 + 32 * (j + ii) + c < 0) S[ii][r] = NEG; }
        }
        const float sink2 = sinks[h] * LOG2E;
        float mx = sink2;
#pragma unroll
        for (int ii = 0; ii < 5; ++ii)
#pragma unroll
            for (int r = 0; r < 16; ++r) mx = __builtin_fmaxf(mx, S[ii][r]);
        { auto rr = __builtin_amdgcn_permlane32_swap(__float_as_uint(mx), __float_as_uint(mx), false, false); mx = __builtin_fmaxf(__uint_as_float(rr[0]), __uint_as_float(rr[1])); }
        float l = 0.f;
#pragma unroll
        for (int ii = 0; ii < 5; ++ii)
#pragma unroll
            for (int r = 0; r < 16; ++r) { const float p = __builtin_amdgcn_exp2f(S[ii][r] - mx); S[ii][r] = p; l += p; }
        { auto rr = __builtin_amdgcn_permlane32_swap(__float_as_uint(l), __float_as_uint(l), false, false); l = __uint_as_float(rr[0]) + __uint_as_float(rr[1]); }
        l += __builtin_amdgcn_exp2f(sink2 - mx);
        if (hi == 0) wsf[32 + r32] = __builtin_amdgcn_rcpf(l);
        f32x16 o[2]; o[0] = f32x16{}; o[1] = f32x16{};
        const lds_cptr vp = (lds_cptr)ldsb + VOFF + buf * UBYTES + ((lane >> 4) & 1) * 32 + (lane & 3) * 8 + (4 * hi + ((lane & 15) >> 2)) * 64;
#pragma unroll
        for (int ii = 0; ii < 5; ++ii) { const int kb = j + ii; const lds_cptr vt = vp + (kb >> 1) * 8192 + (kb & 1) * 2048;
#pragma unroll
            for (int s = 0; s < 2; ++s) {
                v4u pw; pw.x = cvtpk(S[ii][8 * s + 0], S[ii][8 * s + 1]); pw.y = cvtpk(S[ii][8 * s + 2], S[ii][8 * s + 3]); pw.z = cvtpk(S[ii][8 * s + 4], S[ii][8 * s + 5]); pw.w = cvtpk(S[ii][8 * s + 6], S[ii][8 * s + 7]);
                const bf16x8 pa = __builtin_bit_cast(bf16x8, pw);
#pragma unroll
                for (int d0 = 0; d0 < 2; ++d0) { const s16x4 lo = vtr(vt + d0 * 4096 + s * 1024), hh = vtr(vt + d0 * 4096 + s * 1024 + 512);
                    const bf16x8 vf = (bf16x8){lo[0], lo[1], lo[2], lo[3], hh[0], hh[1], hh[2], hh[3]};
                    o[d0] = __builtin_amdgcn_mfma_f32_32x32x16_bf16(pa, vf, o[d0], 0, 0, 0); }
            } }
        asm volatile("s_waitcnt lgkmcnt(0)" ::: "memory");
#pragma unroll
        for (int r = 0; r < 16; ++r) { const int orow = (r & 3) + 8 * (r >> 2) + 4 * hi; const float rl = wsf[32 + orow];
#pragma unroll
            for (int d0 = 0; d0 < 2; ++d0) stg[orow * 64 + d0 * 32 + r32] = (bf16)f2bf(o[d0][r] * rl); }
        asm volatile("s_waitcnt lgkmcnt(0)" ::: "memory");
        const size_t obase = (size_t)(rowbase + q0 + 32 * j) * DM + h * 64;
#pragma unroll
        for (int i4 = 0; i4 < 4; ++i4) { const int row = i4 * 8 + (lane >> 3), ch = lane & 7;
            const v4u ov = *(const LAS v4u*)(stg + row * 64 + ch * 8); const v4u gv = *(const v4u*)(SGb + obase + (size_t)row * DM + ch * 8);
            v4u w; w.x = cvtpk(bf_lo(ov.x) * bf_lo(gv.x), bf_hi(ov.x) * bf_hi(gv.x)); w.y = cvtpk(bf_lo(ov.y) * bf_lo(gv.y), bf_hi(ov.y) * bf_hi(gv.y));
            w.z = cvtpk(bf_lo(ov.z) * bf_lo(gv.z), bf_hi(ov.z) * bf_hi(gv.z)); w.w = cvtpk(bf_lo(ov.w) * bf_lo(gv.w), bf_hi(ov.w) * bf_hi(gv.w));
            *(v4u*)(OGb + obase + (size_t)row * DM + ch * 8) = w; }
    }
    asm volatile("s_waitcnt vmcnt(0) lgkmcnt(0)\n\ts_barrier" ::: "memory");
}
}

struct Args {
    const float* x; const float* c; const int* pos; const float* ada_w; const float* ada_b; const float* norm_g;
    const float* a_win; const float* a_qn; const float* a_kn; const float* a_sink; const float* a_wout;
    const float* p_win; const float* p_wg; const float* p_scale; const float* p_wout;
    float* out; unsigned char* ws; int ph_lo, ph_hi;
};

__device__ __forceinline__ float wave_sum(float v) {
#pragma unroll
    for (int o = 1; o < 64; o <<= 1) v += __shfl_xor(v, o);
    return v;
}
__device__ __forceinline__ int attn_dst_row(int n) {
    const int tile = n >> 8, c = n & 255, wc = c >> 6, d = c & 63;
    int dp = d;
    if (tile < 5 && d < 16) dp = 8 * ((d >> 2) & 1) + 4 * (d >> 3) + (d & 3);
    return tile * 256 + 128 * (dp >> 5) + 32 * wc + (dp & 31);
}
__device__ __forceinline__ void transpose_item(const float* W, int ldw, int ncol0, int K, int nblk, bf16* WT, int row_off, int mode, LAS float* scr, int item, int lane) {
    const int kb = item / nblk, nb = item % nblk, k0 = 64 * kb, n0 = 32 * nb;
#pragma unroll 8
    for (int i = 0; i < 32; ++i) { const int kk = 2 * i + (lane >> 5); scr[kk * 33 + (lane & 31)] = W[(size_t)(k0 + kk) * ldw + ncol0 + n0 + (lane & 31)]; }
    LDS_WAIT(); asm volatile("" ::: "memory");
    const int c = lane & 7;
#pragma unroll
    for (int jj = 0; jj < 4; ++jj) { const int n = (lane >> 3) + 8 * jj; const LAS float* s = scr + (8 * c) * 33 + n;
        v4u o; o.x = pk2(s[0 * 33], s[1 * 33]); o.y = pk2(s[2 * 33], s[3 * 33]); o.z = pk2(s[4 * 33], s[5 * 33]); o.w = pk2(s[6 * 33], s[7 * 33]);
        const int drow = mode ? attn_dst_row(n0 + n) : (n0 + n);
        *(GAS v4u*)(WT + (size_t)(row_off + drow) * K + k0 + 8 * c) = o; }
    LDS_WAIT(); asm volatile("" ::: "memory");
}

__device__ __forceinline__ void phase_p0a(const Args& A, LAS unsigned char* lds, int vcu, int G, int tid, int lane, int wave) {
    unsigned char* ws = A.ws;
    {
        LAS f32x4* sc = (LAS f32x4*)lds;
        LAS float* red = (LAS float*)(lds + 16384);
        bool have = false;
        for (int it = vcu; it < DEPTH * 48; it += G) {
            if (!have) { for (int k = tid; k < DM; k += NWAVES * 64) { f32x4 v; v.x = silu_f(A.c[k]); v.y = silu_f(A.c[DM + k]); v.z = silu_f(A.c[2 * DM + k]); v.w = silu_f(A.c[3 * DM + k]); sc[k] = v; } have = true; }
            __syncthreads();
            const int l = it / 48, jb = it % 48; const int kk = lane >> 4, c4 = lane & 15;
            const float* wp = A.ada_w + ((size_t)l * DM + wave * 128 + kk) * MODW + jb * 64 + 4 * c4;
            f32x4 ac[4]; ac[0] = ac[1] = ac[2] = ac[3] = (f32x4){0.f, 0.f, 0.f, 0.f};
#pragma unroll 8
            for (int i = 0; i < 32; ++i) { const f32x4 w = *(const f32x4*)(wp + (size_t)(4 * i) * MODW); const f32x4 s = sc[wave * 128 + 4 * i + kk];
                ac[0] += w * s.x; ac[1] += w * s.y; ac[2] += w * s.z; ac[3] += w * s.w; }
#pragma unroll
            for (int bb = 0; bb < 4; ++bb)
#pragma unroll
                for (int e = 0; e < 4; ++e) { float v = ac[bb][e]; v += __shfl_xor(v, 16); v += __shfl_xor(v, 32); ac[bb][e] = v; }
            if (kk == 0) {
#pragma unroll
                for (int bb = 0; bb < 4; ++bb) *(LAS f32x4*)(red + (wave * 4 + bb) * 64 + 4 * c4) = ac[bb]; }
            __syncthreads();
            if (tid < 256) { const int bb = tid >> 6, col = tid & 63; float s = 0.f;
#pragma unroll
                for (int w = 0; w < 8; ++w) s += red[(w * 4 + bb) * 64 + col];
                ((float*)(ws + WS_MOD))[((size_t)l * 4 + bb) * MODW + jb * 64 + col] = s + A.ada_b[l * MODW + jb * 64 + col]; }
        }
        __syncthreads();
    }
    LAS float* scr = (LAS float*)(lds + 32768 + wave * 8704);
    const int gw = vcu * NWAVES + wave, NGW = G * NWAVES;
    constexpr int I_AIN = 16 * 80, I_PG = 16 * 32, I_OUT = 16 * 32, I_WG = 4 * 8;
    constexpr int T0 = 2 * I_AIN, T1 = T0 + 2 * I_PG, T2 = T1 + 2 * I_OUT, T3 = T2 + 2 * I_OUT, T4 = T3 + 8 * I_WG, T5 = T4 + 2 * DM, T6 = T5 + (M * 8) / 64;
    for (int it = gw; it < T6; it += NGW) {
        if (it < T0) { const int l = it / I_AIN, r = it % I_AIN; transpose_item(A.a_win + (size_t)l * DM * NAIN, NAIN, 0, DM, 80, (bf16*)(ws + WS_WAIN) + (size_t)l * NAIN * DM, 0, 1, scr, r, lane); }
        else if (it < T1) { const int q = it - T0, l = q / I_PG, r = q % I_PG; transpose_item(A.p_win + (size_t)l * DM * NPIN, NPIN, DM, DM, 32, (bf16*)(ws + WS_WPIN) + (size_t)l * NPIN * DM, DM, 0, scr, r, lane); }
        else if (it < T2) { const int q = it - T1, l = q / I_OUT, r = q % I_OUT; transpose_item(A.a_wout + (size_t)l * DM * DM, DM, 0, DM, 32, (bf16*)(ws + WS_WAOUT) + (size_t)l * DM * DM, 0, 0, scr, r, lane); }
        else if (it < T3) { const int q = it - T2, l = q / I_OUT, r = q % I_OUT; transpose_item(A.p_wout + (size_t)l * DM * DM, DM, 0, DM, 32, (bf16*)(ws + WS_WPOUT) + (size_t)l * DM * DM, 0, 0, scr, r, lane); }
        else if (it < T4) { const int q = it - T3, lg = q / I_WG, r = q % I_WG;
            transpose_item(A.p_wg + (size_t)lg * 65536, 256, 0, 256, 8, (bf16*)(ws + WS_CA) + (size_t)lg * 65536, 0, 0, scr, r, lane); }
        else if (it < T5) { const int q = it - T4, l = q / DM, k = q % DM;
            const float* src = A.p_win + ((size_t)l * DM + k) * NPIN; bf16* dst = (bf16*)(ws + WS_CB) + (size_t)l * 4 * DM * 256 + (size_t)k * 256;
#pragma unroll
            for (int g = 0; g < 4; ++g) { const f32x4 v = *(const f32x4*)(src + g * 256 + 4 * lane); v2u o; o.x = pk2(v[0], v[1]); o.y = pk2(v[2], v[3]); *(v2u*)(dst + (size_t)g * DM * 256 + 4 * lane) = o; } }
        else { const int q = (it - T5) * 64 + lane; const int m = q >> 3, i = q & 7;
            const float invf[8] = {1.0f, 0.1939227432012558f, 0.03760603070259094f, 0.007292664609849453f, 0.0014142135623842478f, 0.00027424818836152554f, 5.318296098266728e-05f, 1.0313386155758053e-05f};
            float fr_ = invf[0];
#pragma unroll
            for (int e = 1; e < 8; ++e) fr_ = (i == e) ? invf[e] : fr_;
            const float ang = (float)A.pos[m] * fr_;
            const double a = (double)ang; const double kq = __builtin_rint(a * 0.63661977236758134308);
            double y = __builtin_fma(-kq, 1.57079632679489655800, a); y = __builtin_fma(-kq, 6.12323399573676603587e-17, y);
            const double y2 = y * y;
            double sp = -2.5052108385441718775e-08; sp = sp * y2 + 2.7557319223985890653e-06; sp = sp * y2 - 1.9841269841269841253e-04; sp = sp * y2 + 8.3333333333333332177e-03; sp = sp * y2 - 1.6666666666666665741e-01; const double sn = y + y * y2 * sp;
            double cp = 2.0876756987868098979e-09; cp = cp * y2 - 2.7557319223985888276e-07; cp = cp * y2 + 2.4801587301587301566e-05; cp = cp * y2 - 1.3888888888888889419e-03; cp = cp * y2 + 4.1666666666666664354e-02; cp = cp * y2 - 0.5; const double cs = 1.0 + y2 * cp;
            const int qd = ((int)(long long)kq) & 3;
            const double s_ = (qd == 0) ? sn : (qd == 1) ? cs : (qd == 2) ? -sn : -cs;
            const double c_ = (qd == 0) ? cs : (qd == 1) ? -sn : (qd == 2) ? -cs : sn;
            ((float*)(ws + WS_ROPE))[q] = (float)c_; ((float*)(ws + WS_ROPE))[(size_t)M * 8 + q] = (float)s_; }
    }
}

__device__ __forceinline__ void phase_p0b(const Args& A, LAS unsigned char* lds, int vcu, int G, int tid, int lane, int wave) {
    unsigned char* ws = A.ws;
    const float* mod = (const float*)(ws + WS_MOD);
    {
        pg8::Gemm g{(const bf16*)(ws + WS_CA), (const bf16*)(ws + WS_CB), 2048, DM, 256, 0, (size_t)DM * 256 * 2}; pg8::StaticOrder S; S.init(2048, DM, G, (int)blockIdx.x);
        pg8::EpiComb E{(bf16*)(ws + WS_WPIN)};
        pg8::gemm_phase<pg8::EpiComb, pg8::StaticOrder, false, true>(lds, g, S, E);
    }
    __syncthreads();
    {
        LAS f32x4* sh = (LAS f32x4*)lds; LAS float* red = (LAS float*)(lds + 16384);
        for (int it = vcu; it < 112; it += G) {
            int mat, nb; if (it < 80) { mat = it / 40; nb = it % 40; } else { mat = 2 + (it - 80) / 16; nb = (it - 80) % 16; }
            const int layer = (mat < 2) ? 2 * mat : 2 * (mat - 2) + 1;
            const float* shp = mod + (size_t)layer * 4 * MODW;
            __syncthreads();
            for (int k = tid; k < DM; k += NWAVES * 64) { f32x4 v; v.x = shp[k]; v.y = shp[MODW + k]; v.z = shp[2 * MODW + k]; v.w = shp[3 * MODW + k]; sh[k] = v; }
            __syncthreads();
            const float* W; int ldw, col; float* dst;
            if (mat < 2) { W = A.a_win + (size_t)mat * DM * NAIN; ldw = NAIN; col = nb * 64; dst = (float*)(ws + WS_SBA) + (size_t)mat * 4 * NAIN + col; }
            else { W = A.p_win + (size_t)(mat - 2) * DM * NPIN; ldw = NPIN; col = DM + nb * 64; dst = (float*)(ws + WS_SBP) + (size_t)(mat - 2) * 4 * DM + nb * 64; }
            const int dstld = (mat < 2) ? NAIN : DM;
            const float* wp = W + (size_t)(wave * 128) * ldw + col + lane;
            float a0 = 0.f, a1 = 0.f, a2 = 0.f, a3 = 0.f;
#pragma unroll 8
            for (int i = 0; i < 128; ++i) { const float w = wp[(size_t)i * ldw]; const f32x4 s = sh[wave * 128 + i]; a0 += w * s.x; a1 += w * s.y; a2 += w * s.z; a3 += w * s.w; }
            red[(wave * 4 + 0) * 64 + lane] = a0; red[(wave * 4 + 1) * 64 + lane] = a1; red[(wave * 4 + 2) * 64 + lane] = a2; red[(wave * 4 + 3) * 64 + lane] = a3;
            __syncthreads();
            if (tid < 256) { const int bb = tid >> 6, cl = tid & 63; float s = 0.f;
#pragma unroll
                for (int w = 0; w < 8; ++w) s += red[(w * 4 + bb) * 64 + cl];
                dst[(size_t)bb * dstld + cl] = s; }
        }
        __syncthreads();
    }
    {
        const int gw = vcu * NWAVES + wave, NGW = G * NWAVES;
        float* rowss = (float*)(ws + WS_ROWSS); bf16* xb = (bf16*)(ws + WS_XB);
        for (int m = gw; m < M; m += NGW) {
            const int b = m >> 12; const float* scl = mod + (size_t)b * MODW + DM;
            const GAS f32x4* xr = (const GAS f32x4*)(A.x + (size_t)m * DM) + lane;
            GAS unsigned long long* o8 = (GAS unsigned long long*)(xb + (size_t)m * DM) + lane;
            float s = 0.f;
#pragma unroll
            for (int jj = 0; jj < 4; ++jj) { const f32x4 v = xr[64 * jj]; s += (v.x * v.x + v.y * v.y) + (v.z * v.z + v.w * v.w);
                const f32x4 g = *(const f32x4*)(A.norm_g + 256 * jj + 4 * lane), sc = *(const f32x4*)(scl + 256 * jj + 4 * lane); const f32x4 y = v * g * (sc + 1.0f);
                o8[64 * jj] = (unsigned long long)pk2(y.x, y.y) | ((unsigned long long)pk2(y.z, y.w) << 32); }
            s = wave_sum(s);
            if (lane == 0) { rowss[m] = s; rowss[M + m] = 0.f; rowss[2 * M + m] = 0.f; rowss[3 * M + m] = 0.f; }
        }
    }
}

__device__ __forceinline__ void phase_pool(const Args& A, int lp, int vcu, int G, int lane, int wave) {
    unsigned char* ws = A.ws; const bf16* U = (const bf16*)(ws + WS_Q); bf16* SG = (bf16*)(ws + WS_SG);
    const int gw = vcu * NWAVES + wave, NGW = G * NWAVES;
    for (int it = gw; it < (M / 32) * 4; it += NGW) {
        const int grp = it & 3, run = it >> 2, t0 = run * 32, pos0 = t0 & (SEQ - 1), w = 2 << grp;
        const int col = grp * 256 + 4 * lane;
        const f32x4 scl = *(const f32x4*)(A.p_scale + (size_t)lp * DM + col);
        const bf16* up = U + (size_t)t0 * DM + col; bf16* gp = SG + (size_t)t0 * DM + col;
        f32x4 S = (f32x4){0.f, 0.f, 0.f, 0.f};
        for (int jj = 1; jj < w; ++jj) if (pos0 - jj >= 0) { const v2u v = *(const v2u*)(up - (size_t)jj * DM); S += (f32x4){bf_lo(v.x), bf_hi(v.x), bf_lo(v.y), bf_hi(v.y)}; }
#pragma unroll 4
        for (int t = 0; t < 32; ++t) {
            const v2u uv = *(const v2u*)(up + (size_t)t * DM); const v2u gv = *(const v2u*)(gp + (size_t)t * DM);
            const f32x4 ut = (f32x4){bf_lo(uv.x), bf_hi(uv.x), bf_lo(uv.y), bf_hi(uv.y)};
            S += ut;
            const int pos = pos0 + t; const float inv = 1.0f / (float)((pos + 1 < w) ? (pos + 1) : w);
            const f32x4 pooled = S * inv - ut;
            const f32x4 o = pooled * scl * (f32x4){bf_lo(gv.x), bf_hi(gv.x), bf_lo(gv.y), bf_hi(gv.y)};
            v2u ov; ov.x = pk2(o[0], o[1]); ov.y = pk2(o[2], o[3]); *(v2u*)(gp + (size_t)t * DM) = ov;
            if (pos - (w - 1) >= 0) { const v2u v = *(const v2u*)(up + ((long)t - (long)(w - 1)) * DM); S -= (f32x4){bf_lo(v.x), bf_hi(v.x), bf_lo(v.y), bf_hi(v.y)}; }
        }
    }
}

constexpr int N_PHASES = 2 + 3 * DEPTH;
__global__ void __launch_bounds__(NWAVES * 64, 2) trunk_fwd(Args Aarg) {
    extern __shared__ __attribute__((aligned(16))) unsigned char lds_[];
    LAS unsigned char* lds = (LAS unsigned char*)lds_;
    volatile LAS unsigned* MISC = (volatile LAS unsigned*)(lds + LDSCTL_OFF);
    const int G = gridDim.x; const int bx = blockIdx.x; const int vcu = (G % 8 == 0) ? (bx % 8) * (G / 8) + bx / 8 : bx;
    { const int tid = threadIdx.x; for (int u = tid; u < (LDS_BYTES - LDSCTL_OFF) / 4; u += NWAVES * 64) ((LAS unsigned*)(lds + LDSCTL_OFF))[u] = 0u; }
    __syncthreads();
    const int ph_lo = Aarg.ph_lo, ph_hi = Aarg.ph_hi;
    XcdBarrier bar; bar.bar = (unsigned*)(Aarg.ws + WS_CTL) + CW_BAR; bar.x = 0; bar.st = nullptr;
    if (ph_hi - ph_lo > 1) bar = xcd_barrier_post((unsigned*)(Aarg.ws + WS_CTL) + CW_BAR, MISC + 8);

#ifndef DBG_MASK
#define DBG_MASK 0xff
#endif
#if defined(__HIP_DEVICE_COMPILE__)
#define LOAD_ARGS() const __attribute__((address_space(4))) Args* ap = (const __attribute__((address_space(4))) Args*)__builtin_amdgcn_kernarg_segment_ptr(); asm volatile("" : "+s"(ap)); const Args A = *ap; \
        int tidp = threadIdx.x; asm volatile("" : "+v"(tidp)); const int lanep = tidp & 63, wavep = __builtin_amdgcn_readfirstlane(tidp >> 6); (void)lanep; (void)wavep
#else
#define LOAD_ARGS() const Args A = Aarg; int tidp = threadIdx.x; const int lanep = tidp & 63, wavep = tidp >> 6; (void)lanep; (void)wavep
#endif
#define GRID_BAR() do { XcdBarrier b2 = bar; asm volatile("" : "+s"(b2.bar)); xcd_barrier(b2); } while (0)
    if (ph_lo <= 0 && 0 < ph_hi) { LOAD_ARGS(); if (DBG_MASK & 1) phase_p0a(A, lds, vcu, G, tidp, lanep, wavep); if (1 < ph_hi) GRID_BAR(); }
    if (ph_lo <= 1 && 1 < ph_hi) { LOAD_ARGS(); if (DBG_MASK & 2) phase_p0b(A, lds, vcu, G, tidp, lanep, wavep); if (2 < ph_hi) GRID_BAR(); }
    for (int ph = (ph_lo > 2 ? ph_lo : 2); ph < ph_hi; ++ph) {
        LOAD_ARGS();
        unsigned char* ws = A.ws;
        const float* mod = (const float*)(ws + WS_MOD);
        float* rowss = (float*)(ws + WS_ROWSS);
        bf16* XB = (bf16*)(ws + WS_XB); bf16* QB = (bf16*)(ws + WS_Q); bf16* SGB = (bf16*)(ws + WS_SG); bf16* KB = (bf16*)(ws + WS_K); bf16* VB = (bf16*)(ws + WS_V);
        {
            const int l = (ph - 2) / 3, sub = (ph - 2) % 3, jl = l >> 1; const bool is_attn = (l & 1) == 0;
            if (sub == 0) {
                if (is_attn) { if (DBG_MASK & 4) {
                    pg8::Gemm g{XB, (const bf16*)(ws + WS_WAIN) + (size_t)jl * NAIN * DM, M, NAIN, DM, 30, 0}; pg8::StaticOrder S; S.init(M, NAIN, G, bx);
                    pg8::EpiAttnIn E{rowss, (const float*)(ws + WS_SBA) + (size_t)jl * 4 * NAIN, A.a_qn + jl * 64, A.a_kn + jl * 64, (const float*)(ws + WS_ROPE), (const float*)(ws + WS_ROPE) + (size_t)M * 8, QB, KB, VB, SGB};
                    pg8::gemm_phase<pg8::EpiAttnIn, pg8::StaticOrder, true, true>(lds, g, S, E); }
                } else if (DBG_MASK & 8) {
                    pg8::Gemm g{XB, (const bf16*)(ws + WS_WPIN) + (size_t)jl * NPIN * DM, M, NPIN, DM, 30, 0}; pg8::StaticOrder S; S.init(M, NPIN, G, bx);
                    pg8::EpiPoolIn E{rowss, (const float*)(ws + WS_SBP) + (size_t)jl * 4 * DM, QB, SGB};
                    pg8::gemm_phase<pg8::EpiPoolIn, pg8::StaticOrder, true, true>(lds, g, S, E);
                }
            } else if (sub == 1) {
                if (is_attn) { if (DBG_MASK & 16) att::attn_phase(lds, QB, KB, VB, SGB, QB, A.a_sink + jl * 16, vcu, G); }
                else if (DBG_MASK & 32) phase_pool(A, jl, vcu, G, lanep, wavep);
            } else if (DBG_MASK & 64) {
                const bf16* Aop = is_attn ? QB : SGB;
                const bf16* Wt = is_attn ? (const bf16*)(ws + WS_WAOUT) + (size_t)jl * DM * DM : (const bf16*)(ws + WS_WPOUT) + (size_t)jl * DM * DM;
                pg8::Gemm g{Aop, Wt, M, DM, DM, 30, 0}; pg8::StaticOrder S; S.init(M, DM, G, bx);
                const bool lastl = (l == DEPTH - 1);
                pg8::EpiOut E{l == 0 ? A.x : A.out, A.out, mod + (size_t)l * 4 * MODW + 2 * DM, lastl ? nullptr : A.norm_g + (size_t)(l + 1) * DM, lastl ? nullptr : mod + (size_t)(l + 1) * 4 * MODW + DM, lastl ? nullptr : XB, rowss};
                pg8::gemm_phase<pg8::EpiOut, pg8::StaticOrder, false, true>(lds, g, S, E);
            }
        }
        if (ph + 1 < ph_hi) GRID_BAR();
    }
}

extern "C" void kernel_launch(void* const* d_in, const int* in_sizes, int n_in, void* d_out, int out_size, void* d_ws, size_t ws_size, hipStream_t stream) {
    static int grid = 0;
    if (grid == 0) {
        if (n_in != 15 || in_sizes[0] != M * DM || out_size != M * DM || ws_size < WS_END) { fprintf(stderr, "kernel_launch: unexpected shapes (n_in %d, in0 %d, out %d, ws %zu); nothing launched\n", n_in, n_in > 0 ? in_sizes[0] : -1, out_size, ws_size); grid = -1; return; }
        int dev = 0, cus = 0, per_cu = 0;
        if (hipGetDevice(&dev) != hipSuccess || hipDeviceGetAttribute(&cus, hipDeviceAttributeMultiprocessorCount, dev) != hipSuccess) { fprintf(stderr, "kernel_launch: device query failed\n"); grid = -1; return; }
        if (hipFuncSetAttribute((const void*)trunk_fwd, hipFuncAttributeMaxDynamicSharedMemorySize, LDS_BYTES) != hipSuccess) { fprintf(stderr, "kernel_launch: hipFuncSetAttribute failed\n"); grid = -1; return; }
        if (hipOccupancyMaxActiveBlocksPerMultiprocessor(&per_cu, (const void*)trunk_fwd, NWAVES * 64, LDS_BYTES) != hipSuccess || per_cu < 1)
            fprintf(stderr, "kernel_launch: note: occupancy query reports %d workgroups per CU\n", per_cu);
        (void)hipGetLastError();
        grid = cus;
        if (grid != 256) fprintf(stderr, "kernel_launch: %d CUs; this kernel is built for 256\n", grid);
    }
    if (grid < 0) return;
    if (hipMemsetAsync((char*)d_ws + WS_CTL, 0, CTL_ZERO_BYTES, stream) != hipSuccess) { fprintf(stderr, "kernel_launch: memset failed\n"); return; }
    Args a{};
    a.x = (const float*)d_in[0]; a.c = (const float*)d_in[1]; a.pos = (const int*)d_in[2]; a.ada_w = (const float*)d_in[3]; a.ada_b = (const float*)d_in[4]; a.norm_g = (const float*)d_in[5];
    a.a_win = (const float*)d_in[6]; a.a_qn = (const float*)d_in[7]; a.a_kn = (const float*)d_in[8]; a.a_sink = (const float*)d_in[9]; a.a_wout = (const float*)d_in[10];
    a.p_win = (const float*)d_in[11]; a.p_wg = (const float*)d_in[12]; a.p_scale = (const float*)d_in[13]; a.p_wout = (const float*)d_in[14];
    a.out = (float*)d_out; a.ws = (unsigned char*)d_ws;
#if MK_ONE_LAUNCH
    a.ph_lo = 0; a.ph_hi = N_PHASES;
    hipLaunchKernelGGL(trunk_fwd, dim3(grid), dim3(NWAVES * 64), LDS_BYTES, stream, a);
#else
    for (int ph = 0; ph < N_PHASES; ++ph) { a.ph_lo = ph; a.ph_hi = ph + 1; hipLaunchKernelGGL(trunk_fwd, dim3(grid), dim3(NWAVES * 64), LDS_BYTES, stream, a); }
#endif
}
```

```cpp
#include <hip/hip_runtime.h>
#include <hip/hip_bf16.h>
#include <cstdio>
#include <cstdint>

#ifndef MK_ONE_LAUNCH
#define MK_ONE_LAUNCH 1
#endif
#ifndef PROBE
#define PROBE 0
#endif

namespace pg8 {
#define PG8_LAS __attribute__((address_space(3)))
typedef unsigned short bf16_t;
typedef short bf16x8 __attribute__((ext_vector_type(8)));
typedef float f32x4 __attribute__((ext_vector_type(4)));
typedef unsigned u32x4 __attribute__((ext_vector_type(4)));
typedef unsigned u32x2 __attribute__((ext_vector_type(2)));
constexpr int BM = 256, BK = 64, HALF = 128, HTB = HALF * BK * 2, STAGE_BYTES = 8 * HTB, NXCD = 8, WGM = 8;

__host__ __device__ __forceinline__ int lds_byte(int r, int c) { const int st = (r >> 4) * 2 + (c >> 5), rr = r & 15, cc = c & 31, ob = rr * 64 + cc * 2; return st * 1024 + (ob ^ (((ob >> 9) & 1) << 5)); }
__host__ __device__ __forceinline__ void stage_rc(int b, int& R, int& C) { const int st = b / 1024, sb = b % 1024, swz = sb ^ (((sb >> 9) & 1) << 5); R = (st >> 1) * 16 + swz / 64; C = (st & 1) * 32 + (swz % 64) / 2; }
__host__ __device__ __forceinline__ int perm32(int rho) { const int n = rho >> 4, i = rho & 15; return 8 * (i >> 2) + 4 * n + (i & 3); }

struct Unit { int pm, pn; };
struct Gemm { const bf16_t* A; const bf16_t* Bt; int M, N, K; int bsh; size_t bstr; };

struct StaticOrder {
    int nM, nN, nwg, G, c;
    __host__ __device__ void init(int M, int N, int G_, int c_) { nM = M / BM; nN = N / BM; nwg = nM * nN; G = G_; c = c_; }
    __host__ __device__ bool next(int i, Unit& u) const {
        const long L = (long)i * G + c; if (L >= nwg) return false;
        int wgid = (int)L; { const int q = nwg / NXCD, r = nwg % NXCD, xcd = wgid % NXCD, off = wgid / NXCD; wgid = (xcd < r ? xcd * (q + 1) : r * (q + 1) + (xcd - r) * q) + off; }
        const int nig = WGM * nN, gid = wgid / nig, fm = gid * WGM, gsz = (nM - fm) < WGM ? (nM - fm) : WGM;
        u.pm = fm + ((wgid % nig) % gsz); u.pn = (wgid % nig) / gsz; return true;
    }
    __device__ __forceinline__ void a_ready(const Unit&) const {}
    __device__ __forceinline__ void done(const Unit&) const {}
};

__device__ __forceinline__ unsigned cvt_pk_bf16(float lo, float hi) { unsigned r; asm volatile("v_cvt_pk_bf16_f32 %0, %1, %2" : "=v"(r) : "v"(lo), "v"(hi)); return r; }

template <class Epi, class Sched, bool ALIGN_EPI = false, bool SP2 = false>
__device__ __forceinline__ void gemm_phase(PG8_LAS unsigned char* lds, const Gemm g, const Sched& S, const Epi& E) {
    int tid_ = threadIdx.x; asm volatile("" : "+v"(tid_));
    const int tid = tid_, wid = __builtin_amdgcn_readfirstlane(tid >> 6), lane = tid & 63, wr = wid >> 2, wc = wid & 3, fr = lane & 15, fq = lane >> 4;
    const int K = g.K, nt = K / BK;
    unsigned voffA[2], voffB[2];
#pragma unroll
    for (int i = 0; i < 2; ++i) { int R, C; stage_rc(tid * 16 + i * 8192, R, C); const int Rb = Epi::PERM ? ((R & ~31) + perm32(R & 31)) : R;
        voffA[i] = (unsigned)(R * K + C) * 2u; voffB[i] = (unsigned)(Rb * K + C) * 2u; }
    const size_t kstep = (size_t)(BK * 2);
    const size_t hstep = (size_t)HALF * K * 2;
    const size_t tstep = 2 * hstep;
    const unsigned ldsw = (unsigned)wid * 1024u;
    const int aoff = lds_byte(wr * 64 + fr, fq * 8), boff = lds_byte(wc * 32 + fr, fq * 8);
#define PG8_SA(b, h) (((b) * 2 + (h)) * HTB)
#define PG8_SB(b, h) ((4 + (b) * 2 + (h)) * HTB)
#define PG8_STAGE(bufoff, gbase, voff) do { _Pragma("unroll") for (int _i = 0; _i < 2; ++_i) \
        __builtin_amdgcn_global_load_lds((const unsigned*)((const char*)(gbase) + (voff)[_i]), (PG8_LAS unsigned*)(lds + (bufoff) + ldsw + _i * 8192), 16, 0, 0); } while (0)
#define PG8_LDA(dst, b, h) do { _Pragma("unroll") for (int m = 0; m < 4; ++m) _Pragma("unroll") for (int k = 0; k < 2; ++k) dst[m][k] = *(const PG8_LAS bf16x8*)(lds + PG8_SA(b, h) + aoff + m * 2048 + k * 1024); } while (0)
#define PG8_LDB(dst, b, h) do { _Pragma("unroll") for (int n = 0; n < 2; ++n) _Pragma("unroll") for (int k = 0; k < 2; ++k) dst[n][k] = *(const PG8_LAS bf16x8*)(lds + PG8_SB(b, h) + boff + n * 2048 + k * 1024); } while (0)
#define PG8_MMA(ai, bj, At, Bt) do { __builtin_amdgcn_s_setprio(1); _Pragma("unroll") for (int m = 0; m < 4; ++m) _Pragma("unroll") for (int n = 0; n < 2; ++n) _Pragma("unroll") for (int k = 0; k < 2; ++k) \
        acc[ai][bj][m][n] = __builtin_amdgcn_mfma_f32_16x16x32_bf16(Bt[n][k], At[m][k], acc[ai][bj][m][n], 0, 0, 0); __builtin_amdgcn_s_setprio(0); } while (0)
#define PG8_WAIT_V(n) asm volatile("s_waitcnt vmcnt(" #n ")" ::: "memory")
#define PG8_WAIT_L(n) asm volatile("s_waitcnt lgkmcnt(" #n ")" ::: "memory")
#define PG8_BAR __builtin_amdgcn_s_barrier()
#define PG8_SCHED __builtin_amdgcn_sched_barrier(0)
    Unit cur, nxt; int ui = 0;
    if (!S.next(0, cur)) return;
    f32x4 acc[2][2][4][2];
#pragma unroll
    for (int a = 0; a < 2; ++a)
#pragma unroll
        for (int b = 0; b < 2; ++b)
#pragma unroll
            for (int m = 0; m < 4; ++m)
#pragma unroll
                for (int n = 0; n < 2; ++n) acc[a][b][m][n] = (f32x4){0.f, 0.f, 0.f, 0.f};
    bf16x8 At[4][2], B0[2][2], B1[2][2];
    const char* cA = (const char*)g.A + (size_t)cur.pm * tstep; const char* cB = (const char*)g.Bt + (size_t)(cur.pm >> g.bsh) * g.bstr + (size_t)cur.pn * tstep;
    S.a_ready(cur);
    if constexpr (SP2) {
        PG8_STAGE(PG8_SB(0, 0), cB, voffB); PG8_STAGE(PG8_SB(0, 1), cB + hstep, voffB); PG8_STAGE(PG8_SA(0, 0), cA, voffA); PG8_STAGE(PG8_SA(0, 1), cA + hstep, voffA);
        if (wr == 1) PG8_BAR;
        PG8_WAIT_V(2); PG8_BAR;
        PG8_STAGE(PG8_SB(1, 0), cB + kstep, voffB); PG8_STAGE(PG8_SA(1, 0), cA + kstep, voffA); PG8_STAGE(PG8_SB(1, 1), cB + hstep + kstep, voffB);
        PG8_WAIT_V(6); PG8_BAR;
    } else {
        PG8_STAGE(PG8_SB(0, 0), cB, voffB); PG8_STAGE(PG8_SA(0, 0), cA, voffA); PG8_STAGE(PG8_SB(0, 1), cB + hstep, voffB); PG8_STAGE(PG8_SA(0, 1), cA + hstep, voffA);
        if (wr == 1) PG8_BAR;
        PG8_WAIT_V(4); PG8_BAR;
        PG8_STAGE(PG8_SB(1, 0), cB + kstep, voffB); PG8_STAGE(PG8_SA(1, 0), cA + kstep, voffA); PG8_STAGE(PG8_SB(1, 1), cB + hstep + kstep, voffB);
        PG8_WAIT_V(6); PG8_BAR;
    }
    for (;;) {
        const bool has_next = S.next(ui + 1, nxt);
        const char* nA = has_next ? (const char*)g.A + (size_t)nxt.pm * tstep : cA; const char* nB = has_next ? (const char*)g.Bt + (size_t)(nxt.pm >> g.bsh) * g.bstr + (size_t)nxt.pn * tstep : cB;
        for (int t = 0; t < nt; t += 2) {
            const bool last = (t == nt - 2);
            const char* a1 = cA + (size_t)(t + 1) * kstep;
            const char* a2 = last ? nA : cA + (size_t)(t + 2) * kstep; const char* b2 = last ? nB : cB + (size_t)(t + 2) * kstep;
            const char* a3 = a2 + kstep; const char* b3 = b2 + kstep;
            if (last && has_next) S.a_ready(nxt);
            if constexpr (SP2) {
            PG8_LDB(B0, 0, 0); PG8_LDB(B1, 0, 1); PG8_SCHED; PG8_LDA(At, 0, 0); PG8_STAGE(PG8_SA(1, 1), a1 + hstep, voffA);
            PG8_WAIT_V(8); PG8_WAIT_L(0); PG8_BAR; PG8_MMA(0, 0, At, B0); PG8_MMA(0, 1, At, B1); PG8_BAR; PG8_SCHED;
            PG8_LDA(At, 0, 1); PG8_STAGE(PG8_SB(0, 0), b2, voffB); PG8_STAGE(PG8_SB(0, 1), b2 + hstep, voffB); PG8_STAGE(PG8_SA(0, 0), a2, voffA);
            PG8_WAIT_V(8); PG8_WAIT_L(0); PG8_BAR; PG8_MMA(1, 0, At, B0); PG8_MMA(1, 1, At, B1); PG8_BAR; PG8_SCHED;
            PG8_LDB(B0, 1, 0); PG8_LDB(B1, 1, 1); PG8_SCHED; PG8_LDA(At, 1, 0); PG8_STAGE(PG8_SA(0, 1), a2 + hstep, voffA);
            PG8_WAIT_V(8); PG8_WAIT_L(0); PG8_BAR; PG8_MMA(0, 0, At, B0); PG8_MMA(0, 1, At, B1); PG8_BAR; PG8_SCHED;
            PG8_LDA(At, 1, 1); PG8_STAGE(PG8_SB(1, 0), b3, voffB); PG8_STAGE(PG8_SB(1, 1), b3 + hstep, voffB); PG8_STAGE(PG8_SA(1, 0), a3, voffA);
            PG8_WAIT_V(8); PG8_WAIT_L(0); PG8_BAR; PG8_MMA(1, 0, At, B0); PG8_MMA(1, 1, At, B1); PG8_BAR; PG8_SCHED;
            } else {
            PG8_LDB(B0, 0, 0); PG8_SCHED; PG8_LDA(At, 0, 0); PG8_STAGE(PG8_SA(1, 1), a1 + hstep, voffA);
            PG8_WAIT_L(8); PG8_BAR; PG8_WAIT_L(0); PG8_MMA(0, 0, At, B0); PG8_BAR; PG8_SCHED;
            PG8_LDB(B1, 0, 1); PG8_STAGE(PG8_SB(0, 0), b2, voffB);
            PG8_BAR; PG8_WAIT_L(0); PG8_MMA(0, 1, At, B1); PG8_BAR;
            PG8_LDA(At, 0, 1); PG8_STAGE(PG8_SA(0, 0), a2, voffA);
            PG8_BAR; PG8_WAIT_L(0); PG8_MMA(1, 0, At, B0); PG8_BAR; PG8_SCHED;
            PG8_STAGE(PG8_SB(0, 1), b2 + hstep, voffB);
            PG8_WAIT_V(6); PG8_BAR; PG8_MMA(1, 1, At, B1); PG8_BAR;
            PG8_LDB(B0, 1, 0); PG8_SCHED; PG8_LDA(At, 1, 0); PG8_STAGE(PG8_SA(0, 1), a2 + hstep, voffA);
            PG8_WAIT_L(8); PG8_BAR; PG8_WAIT_L(0); PG8_MMA(0, 0, At, B0); PG8_BAR; PG8_SCHED;
            PG8_LDB(B1, 1, 1); PG8_STAGE(PG8_SB(1, 0), b3, voffB);
            PG8_BAR; PG8_WAIT_L(0); PG8_MMA(0, 1, At, B1); PG8_BAR;
            PG8_LDA(At, 1, 1); PG8_STAGE(PG8_SA(1, 0), a3, voffA);
            PG8_BAR; PG8_WAIT_L(0); PG8_MMA(1, 0, At, B0); PG8_BAR; PG8_SCHED;
            PG8_STAGE(PG8_SB(1, 1), b3 + hstep, voffB);
            PG8_WAIT_V(6); PG8_BAR; PG8_MMA(1, 1, At, B1); PG8_BAR;
            }
        }
        if constexpr (ALIGN_EPI) { if (wr == 0) PG8_BAR; }
        if constexpr (!Epi::AFTER_DRAIN) { E(acc, cur, wr, wc, fr, fq); S.done(cur); }
        if (!has_next) break;
#pragma unroll
        for (int a = 0; a < 2; ++a)
#pragma unroll
            for (int b = 0; b < 2; ++b)
#pragma unroll
                for (int m = 0; m < 4; ++m)
#pragma unroll
                    for (int n = 0; n < 2; ++n) acc[a][b][m][n] = (f32x4){0.f, 0.f, 0.f, 0.f};
        cur = nxt; cA = nA; cB = nB; ++ui;
        if constexpr (ALIGN_EPI) { if (wr == 1) PG8_BAR; }
    }
    PG8_WAIT_V(0);
    if constexpr (!ALIGN_EPI) { if (wr == 0) PG8_BAR; }
    PG8_BAR;
    if constexpr (Epi::AFTER_DRAIN) { E.fused(acc, cur, wr, wc, fr, fq, lds, wid, lane); S.done(cur); }
#undef PG8_SA
#undef PG8_SB
#undef PG8_STAGE
#undef PG8_LDA
#undef PG8_LDB
#undef PG8_MMA
#undef PG8_WAIT_V
#undef PG8_WAIT_L
#undef PG8_BAR
#undef PG8_SCHED
}
}

constexpr int BATCH = 4, SEQ = 4096, DM = 1024, M = BATCH * SEQ, DEPTH = 4;
constexpr int NAIN = 2560, NPIN = 2048, MODW = 3072;
constexpr float NORM_EPS = 1e-6f, LOG2E = 1.4426950408889634f, C2 = 0.125f * 1.4426950408889634f;
constexpr int NWAVES = 8;

constexpr size_t MiB = 1u << 20, KiB = 1024;
constexpr size_t WS_CTL = 0, CTL_ZERO_BYTES = 1 * MiB;
constexpr size_t WS_MOD = 1 * MiB;
constexpr size_t WS_SBA = 1 * MiB + 256 * KiB;
constexpr size_t WS_SBP = 1 * MiB + 384 * KiB;
constexpr size_t WS_ROWSS = 1 * MiB + 512 * KiB;
constexpr size_t WS_ROPE = 2 * MiB;
constexpr size_t WS_WAIN = 4 * MiB;
constexpr size_t WS_WPIN = 14 * MiB;
constexpr size_t WS_WAOUT = 22 * MiB;
constexpr size_t WS_WPOUT = 26 * MiB;
constexpr size_t WS_CA = 30 * MiB;
constexpr size_t WS_CB = 31 * MiB;
constexpr size_t WS_XB = 36 * MiB;
constexpr size_t WS_Q = 68 * MiB;
constexpr size_t WS_SG = 100 * MiB;
constexpr size_t WS_K = 132 * MiB;
constexpr size_t WS_V = 140 * MiB;
constexpr size_t WS_END = 148 * MiB;
constexpr int CW_BAR = 4096;

constexpr int RING_BYTES = 131072;
constexpr int LDSCTL_OFF = 135168, LDS_BYTES = 139264;

#define GAS __attribute__((address_space(1)))
#define LAS __attribute__((address_space(3)))
typedef unsigned short bf16;
typedef unsigned v4u __attribute__((ext_vector_type(4)));
typedef unsigned v2u __attribute__((ext_vector_type(2)));
typedef float f32x4 __attribute__((ext_vector_type(4)));
typedef float f32x16 __attribute__((ext_vector_type(16)));
typedef short bf16x8 __attribute__((ext_vector_type(8)));
typedef short s16x4 __attribute__((ext_vector_type(4)));
typedef GAS unsigned gu32;
#define RLX_AGENT __ATOMIC_RELAXED, __HIP_MEMORY_SCOPE_AGENT
#define LDS_WAIT() asm volatile("s_waitcnt lgkmcnt(0)" ::: "memory")
#define VM_WAIT() asm volatile("s_waitcnt vmcnt(0)" ::: "memory")
__device__ __forceinline__ unsigned f2bf(float f) { unsigned u = __builtin_bit_cast(unsigned, f); return (u + 0x7fffu + ((u >> 16) & 1u)) >> 16; }
__device__ __forceinline__ unsigned pk2(float lo, float hi) { return f2bf(lo) | (f2bf(hi) << 16); }
__device__ __forceinline__ float bf_lo(unsigned w) { return __builtin_bit_cast(float, w << 16); }
__device__ __forceinline__ float bf_hi(unsigned w) { return __builtin_bit_cast(float, w & 0xffff0000u); }
__device__ __forceinline__ float silu_f(float v) { return v * __builtin_amdgcn_rcpf(1.0f + __builtin_amdgcn_exp2f(-v * LOG2E)); }

#define XB_TMO      128
#define XB_XCNT(j)  (256  + 64 * (j))
#define XB_XSUB(j)  (1280 + 64 * (j))
#define XB_XGEN(j)  (2304 + 64 * (j))
#define XB_TOP      3328
#define XB_TOPGEN   3392
#define XCD_BAR_WORDS 3456
#define XB_SPIN_CAP (1u << 18)
__device__ __forceinline__ unsigned xb_ld(unsigned* p)              { return __hip_atomic_load(p, __ATOMIC_RELAXED, __HIP_MEMORY_SCOPE_AGENT); }
__device__ __forceinline__ unsigned xb_add(unsigned* p, unsigned v) { return __hip_atomic_fetch_add(p, v, __ATOMIC_RELAXED, __HIP_MEMORY_SCOPE_AGENT); }
__device__ __forceinline__ unsigned xb_xcc_id() { return (unsigned)__builtin_amdgcn_s_getreg((3 << 11) | 20) & 0xFu; }
#define XB_SPIN(cond, bar) do { unsigned _sp = 0; while (cond) { __builtin_amdgcn_s_sleep(1); \
    if ((++_sp & 255u) == 0u) { if (xb_ld(&(bar)[XB_TMO])) break; if (_sp > XB_SPIN_CAP) { atomicAdd(&(bar)[XB_TMO], 1u); break; } } } } while (0)
struct XcdBarrier { unsigned* bar; unsigned x; volatile LAS unsigned* st; };
__device__ __forceinline__ XcdBarrier xcd_barrier_post(unsigned* bar, volatile LAS unsigned* st) {
    XcdBarrier b; b.bar = bar; b.x = xb_xcc_id(); b.st = st;
    if (threadIdx.x == 0) (void)xb_add(&bar[XB_XCNT(b.x)], 1u);
    return b;
}
__device__ __forceinline__ void xcd_barrier_complete(unsigned* bar, unsigned x, unsigned& nloc, unsigned& nx) {
    const unsigned G = gridDim.x * gridDim.y * gridDim.z;
    unsigned sum, cnt, mine, sp = 0u;
    for (;;) {
        sum = 0u; cnt = 0u; mine = 0u;
#pragma unroll
        for (unsigned j = 0; j < 16; ++j) { const unsigned c = xb_ld(&bar[XB_XCNT(j)]); sum += c; cnt += (c > 0u) ? 1u : 0u; mine = (j == x) ? c : mine; }
        if (sum == G) break;
        __builtin_amdgcn_s_sleep(1);
        if ((++sp & 255u) == 0u) { if (xb_ld(&bar[XB_TMO])) break; if (sp > XB_SPIN_CAP) { atomicAdd(&bar[XB_TMO], 1u); break; } }
    }
    nloc = mine > 0u ? mine : 1u; nx = cnt > 0u ? cnt : 1u;
}
__device__ __forceinline__ void xcd_barrier(const XcdBarrier& b) {
    asm volatile("s_waitcnt vmcnt(0)" ::: "memory");
    __syncthreads();
    if (threadIdx.x == 0) {
        unsigned* bar = b.bar;
        __builtin_amdgcn_s_waitcnt(0);
        unsigned nloc = b.st[0], nx = b.st[1];
        if (nloc == 0u) { xcd_barrier_complete(bar, b.x, nloc, nx); b.st[0] = nloc; b.st[1] = nx; }
        const unsigned old = xb_add(&bar[XB_XSUB(b.x)], 1u);
        const unsigned gen = old / nloc;
        if (old + 1u == (gen + 1u) * nloc) {
            __builtin_amdgcn_fence(__ATOMIC_RELEASE, "agent");
            asm volatile("s_waitcnt vmcnt(0)" ::: "memory");
            const unsigned og = xb_add(&bar[XB_TOP], 1u);
            const unsigned tg = og / nx;
            if (og + 1u == (tg + 1u) * nx) xb_add(&bar[XB_TOPGEN], 1u);
            else XB_SPIN(xb_ld(&bar[XB_TOPGEN]) == tg, bar);
            __builtin_amdgcn_fence(__ATOMIC_ACQUIRE, "agent");
            xb_add(&bar[XB_XGEN(b.x)], 1u);
            asm volatile("s_waitcnt vmcnt(0)" ::: "memory");
        } else {
            XB_SPIN(xb_ld(&bar[XB_XGEN(b.x)]) == gen, bar);
            __builtin_amdgcn_fence(__ATOMIC_ACQUIRE, "agent");
            asm volatile("s_waitcnt vmcnt(0)" ::: "memory");
        }
    }
    __syncthreads();
}

namespace pg8 {
__device__ __forceinline__ float row_rstd(const float* rowss, int row) {
    const float s = (rowss[row] + rowss[M + row]) + (rowss[2 * M + row] + rowss[3 * M + row]);
    return __builtin_amdgcn_rsqf(s * (1.0f / DM) + NORM_EPS);
}
__device__ __forceinline__ u32x4 pack8(const f32x4 a, const f32x4 b) { u32x4 w; w.x = cvt_pk_bf16(a[0], a[1]); w.y = cvt_pk_bf16(a[2], a[3]); w.z = cvt_pk_bf16(b[0], b[1]); w.w = cvt_pk_bf16(b[2], b[3]); return w; }

struct EpiAttnIn {
    static constexpr bool PERM = true, AFTER_DRAIN = false;
    const float* rowss; const float* sb; const float* qg; const float* kg; const float* rcos; const float* rsin; bf16_t *Q, *K, *V, *SG;
    __device__ __forceinline__ void operator()(const f32x4 (&acc)[2][2][4][2], const Unit& u, int wr, int wc, int fr, int fq) const {
        const int b = u.pm >> 4, pn = u.pn;
        const bool qk = pn < 5;
        int dl[2][2];
#pragma unroll
        for (int bj = 0; bj < 2; ++bj)
#pragma unroll
            for (int n = 0; n < 2; ++n) dl[bj][n] = (qk && bj == 0 && fq < 2) ? (4 * fq + 8 * n) : (32 * bj + 8 * fq + 4 * n);
        const float* sbp = sb + b * NAIN + pn * 256 + 64 * wc;
        f32x4 sbv[2][2];
#pragma unroll
        for (int bj = 0; bj < 2; ++bj)
#pragma unroll
            for (int n = 0; n < 2; ++n) sbv[bj][n] = *(const f32x4*)(sbp + dl[bj][n]);
        const int row0 = u.pm * BM + wr * 64 + fr;
        if (qk) {
            const float* gp = (pn < 4) ? qg : kg;
            f32x4 gv[2][2];
#pragma unroll
            for (int bj = 0; bj < 2; ++bj)
#pragma unroll
                for (int n = 0; n < 2; ++n) gv[bj][n] = *(const f32x4*)(gp + dl[bj][n]);
            const float osc = (pn < 4) ? C2 : 1.0f;
            bf16_t* obase = (pn < 4) ? (Q + pn * 256 + 64 * wc + 8 * fq) : (K + 64 * wc + 8 * fq);
            const int ld = (pn < 4) ? DM : 256;
#pragma unroll
            for (int ai = 0; ai < 2; ++ai)
#pragma unroll
                for (int m = 0; m < 4; ++m) {
                    const int row = row0 + ai * HALF + m * 16;
                    const float rs = row_rstd(rowss, row);
                    const f32x4 cs = *(const f32x4*)(rcos + (size_t)row * 8 + 4 * (fq & 1)), sn = *(const f32x4*)(rsin + (size_t)row * 8 + 4 * (fq & 1));
                    f32x4 v[2][2]; float ss = 0.f;
#pragma unroll
                    for (int bj = 0; bj < 2; ++bj)
#pragma unroll
                        for (int n = 0; n < 2; ++n) { v[bj][n] = acc[ai][bj][m][n] * rs + sbv[bj][n]; const f32x4 t = v[bj][n] * v[bj][n]; ss += (t[0] + t[1]) + (t[2] + t[3]); }
                    ss += __shfl_xor(ss, 16); ss += __shfl_xor(ss, 32);
                    const float rq = __builtin_amdgcn_rsqf(ss * (1.0f / 64.0f) + NORM_EPS);
#pragma unroll
                    for (int bj = 0; bj < 2; ++bj)
#pragma unroll
                        for (int n = 0; n < 2; ++n) v[bj][n] = v[bj][n] * rq * gv[bj][n];
                    if (fq < 2) { const f32x4 x1 = v[0][0], x2 = v[0][1]; v[0][0] = x1 * cs - x2 * sn; v[0][1] = x2 * cs + x1 * sn; }
#pragma unroll
                    for (int bj = 0; bj < 2; ++bj) *(u32x4*)(obase + (size_t)row * ld + 32 * bj) = pack8(v[bj][0] * osc, v[bj][1] * osc);
                    asm volatile("" ::: "memory");
                }
        } else if (pn == 5) {
            bf16_t* obase = V + 64 * wc + 8 * fq;
#pragma unroll
            for (int ai = 0; ai < 2; ++ai)
#pragma unroll
                for (int m = 0; m < 4; ++m) {
                    const int row = row0 + ai * HALF + m * 16;
                    const float rs = row_rstd(rowss, row);
#pragma unroll
                    for (int bj = 0; bj < 2; ++bj) *(u32x4*)(obase + (size_t)row * 256 + 32 * bj) = pack8(acc[ai][bj][m][0] * rs + sbv[bj][0], acc[ai][bj][m][1] * rs + sbv[bj][1]);
                    asm volatile("" ::: "memory");
                }
        } else {
            bf16_t* obase = SG + (pn - 6) * 256 + 64 * wc + 8 * fq;
#pragma unroll
            for (int ai = 0; ai < 2; ++ai)
#pragma unroll
                for (int m = 0; m < 4; ++m) {
                    const int row = row0 + ai * HALF + m * 16;
                    const float rs = row_rstd(rowss, row);
#pragma unroll
                    for (int bj = 0; bj < 2; ++bj) { f32x4 a = acc[ai][bj][m][0] * rs + sbv[bj][0], c = acc[ai][bj][m][1] * rs + sbv[bj][1];
#pragma unroll
                        for (int e = 0; e < 4; ++e) { a[e] = silu_f(a[e]); c[e] = silu_f(c[e]); }
                        *(u32x4*)(obase + (size_t)row * DM + 32 * bj) = pack8(a, c); }
                    asm volatile("" ::: "memory");
                }
        }
    }
};

struct EpiPoolIn {
    static constexpr bool PERM = true, AFTER_DRAIN = false;
    const float* rowss; const float* sb; bf16_t *U, *SG; float* U32;
    __device__ __forceinline__ void operator()(const f32x4 (&acc)[2][2][4][2], const Unit& u, int wr, int wc, int fr, int fq) const {
        const int b = u.pm >> 4, pn = u.pn;
        const int row0 = u.pm * BM + wr * 64 + fr, colw = wc * 32 + 8 * fq;
        if (pn < 4 && U32) {
#pragma unroll
            for (int ai = 0; ai < 2; ++ai)
#pragma unroll
                for (int m = 0; m < 4; ++m) { const int row = row0 + ai * HALF + m * 16; const float rs = row_rstd(rowss, row);
#pragma unroll
                    for (int bj = 0; bj < 2; ++bj)
#pragma unroll
                        for (int n = 0; n < 2; ++n) *(f32x4*)(U32 + (size_t)row * DM + pn * 256 + colw + bj * HALF + 4 * n) = acc[ai][bj][m][n] * rs; }
        } else if (pn < 4) {
            bf16_t* obase = U + pn * 256 + colw;
#pragma unroll
            for (int ai = 0; ai < 2; ++ai)
#pragma unroll
                for (int m = 0; m < 4; ++m) {
                    const int row = row0 + ai * HALF + m * 16;
                    const float rs = row_rstd(rowss, row);
#pragma unroll
                    for (int bj = 0; bj < 2; ++bj) *(u32x4*)(obase + (size_t)row * DM + bj * HALF) = pack8(acc[ai][bj][m][0] * rs, acc[ai][bj][m][1] * rs);
                    asm volatile("" ::: "memory");
                }
        } else {
            const float* sbp = sb + b * DM + (pn - 4) * 256 + colw;
            f32x4 sbv[2][2];
#pragma unroll
            for (int bj = 0; bj < 2; ++bj)
#pragma unroll
                for (int n = 0; n < 2; ++n) sbv[bj][n] = *(const f32x4*)(sbp + bj * HALF + 4 * n);
            bf16_t* obase = SG + (pn - 4) * 256 + colw;
#pragma unroll
            for (int ai = 0; ai < 2; ++ai)
#pragma unroll
                for (int m = 0; m < 4; ++m) {
                    const int row = row0 + ai * HALF + m * 16;
                    const float rs = row_rstd(rowss, row);
#pragma unroll
                    for (int bj = 0; bj < 2; ++bj) { f32x4 a = acc[ai][bj][m][0] * rs + sbv[bj][0], c = acc[ai][bj][m][1] * rs + sbv[bj][1];
#pragma unroll
                        for (int e = 0; e < 4; ++e) { a[e] = silu_f(a[e]); c[e] = silu_f(c[e]); }
                        *(u32x4*)(obase + (size_t)row * DM + bj * HALF) = pack8(a, c); }
                    asm volatile("" ::: "memory");
                }
        }
    }
};

struct EpiComb {
    static constexpr bool PERM = true, AFTER_DRAIN = false;
    bf16_t* O;
    __device__ __forceinline__ void operator()(const f32x4 (&acc)[2][2][4][2], const Unit& u, int wr, int wc, int fr, int fq) const {
        const int rowt = (u.pm >> 2) * NPIN + (u.pm & 3) * 256 + wr * 64 + fr, col0 = u.pn * BM + wc * 32 + 8 * fq;
#pragma unroll
        for (int ai = 0; ai < 2; ++ai)
#pragma unroll
            for (int m = 0; m < 4; ++m) { bf16_t* rowp = O + (size_t)(rowt + ai * HALF + m * 16) * DM + col0;
#pragma unroll
                for (int bj = 0; bj < 2; ++bj) *(u32x4*)(rowp + bj * HALF) = pack8(acc[ai][bj][m][0], acc[ai][bj][m][1]); }
    }
};

struct EpiOut {
    static constexpr bool PERM = false, AFTER_DRAIN = true;
    const float* xin; float* xout; const float* gate;   const float* ng_next; const float* scale_next; bf16_t* xb; float* rowss;
    __device__ __forceinline__ void fused(f32x4 (&acc)[2][2][4][2], const Unit& u, int wr, int wc, int fr, int fq, PG8_LAS unsigned char* lds, int wid, int lane) const {
        const int b = u.pm >> 4;
        const int col0 = u.pn * BM + wc * 32 + 4 * fq;
        const bool nxt = (xb != nullptr);
        f32x4 gt[2][2], fd[2][2];
#pragma unroll
        for (int bj = 0; bj < 2; ++bj)
#pragma unroll
            for (int n = 0; n < 2; ++n) { const int c = col0 + bj * HALF + n * 16;
                gt[bj][n] = *(const f32x4*)(gate + b * MODW + c);
                if (nxt) { const f32x4 g = *(const f32x4*)(ng_next + c), s = *(const f32x4*)(scale_next + b * MODW + c); fd[bj][n] = g * (s + 1.0f); } else fd[bj][n] = (f32x4){0.f, 0.f, 0.f, 0.f}; }
        PG8_LAS float* P = (PG8_LAS float*)lds;
#pragma unroll
        for (int ai = 0; ai < 2; ++ai)
#pragma unroll
            for (int m = 0; m < 4; ++m) {
                const int rt = ai * HALF + wr * 64 + m * 16 + fr; const size_t off = (size_t)(u.pm * BM + rt) * DM + col0;
                float ss = 0.f;
#pragma unroll
                for (int bj = 0; bj < 2; ++bj)
#pragma unroll
                    for (int n = 0; n < 2; ++n) { const f32x4 xo = *(const f32x4*)(xin + off + bj * HALF + n * 16); const f32x4 xn = xo + gt[bj][n] * acc[ai][bj][m][n];
                        *(f32x4*)(xout + off + bj * HALF + n * 16) = xn; const f32x4 t = xn * xn; ss += (t[0] + t[1]) + (t[2] + t[3]);
                        if (nxt) { const f32x4 y = xn * fd[bj][n]; u32x2 w; w.x = cvt_pk_bf16(y[0], y[1]); w.y = cvt_pk_bf16(y[2], y[3]); *(u32x2*)(xb + off + bj * HALF + n * 16) = w; } }
                ss += __shfl_xor(ss, 16); ss += __shfl_xor(ss, 32);
                if (nxt && fq == 0) P[rt * 4 + wc] = ss;
                asm volatile("" ::: "memory");
            }
        if (nxt) {
            asm volatile("s_waitcnt lgkmcnt(0)" ::: "memory"); __builtin_amdgcn_s_barrier(); asm volatile("" ::: "memory");
            const int t = wid * 64 + lane;
            if (t < 256) { const float s = (P[t * 4 + 0] + P[t * 4 + 1]) + (P[t * 4 + 2] + P[t * 4 + 3]); rowss[(size_t)u.pn * M + u.pm * BM + t] = s; }
            asm volatile("s_waitcnt lgkmcnt(0)" ::: "memory"); __builtin_amdgcn_s_barrier(); asm volatile("" ::: "memory");
        }
    }
};
}

namespace att {
typedef LAS const char* lds_cptr;
typedef LAS char* lds_ptr;
typedef short v4i16_t __attribute__((ext_vector_type(4)));
constexpr int KOFF = 0, VOFF = 49152, UBYTES = 24576, WSFOFF = 98304, OSTOFF = 100352;
__device__ __forceinline__ void glds16(const void* gsrc, unsigned lds_dst) { unsigned keep;
    asm volatile("s_mov_b32 %0, m0\n\ts_mov_b32 m0, %2\n\ts_nop 0\n\tglobal_load_lds_dwordx4 %1, off\n\ts_mov_b32 m0, %0" : "=&s"(keep) : "v"(gsrc), "s"(lds_dst) : "memory"); }
__device__ __forceinline__ s16x4 vtr(lds_cptr p) { return __builtin_bit_cast(s16x4, __builtin_amdgcn_ds_read_tr16_b64_v4i16((LAS v4i16_t*)p)); }
__device__ __forceinline__ unsigned cvtpk(float lo, float hi) { unsigned r; asm("v_cvt_pk_bf16_f32 %0, %1, %2" : "=v"(r) : "v"(lo), "v"(hi)); return r; }

__device__ __forceinline__ void dma_unit(const bf16* Kb, const bf16* Vb, int uid, int buf, unsigned lds0, int wid, int lane) {
    const int b = uid >> 8, kvh = (uid >> 6) & 3, qb = uid & 63, q0 = qb * 64; const long rowbase = (long)b * SEQ;
#pragma unroll
    for (int t = 0; t < 3; ++t) { int key = q0 - 128 + 64 * t + lane; key = key < 0 ? 0 : key;
        glds16(Kb + (rowbase + key) * 256 + kvh * 64 + wid * 8, (unsigned)__builtin_amdgcn_readfirstlane(lds0 + KOFF + buf * UBYTES + t * 8192 + wid * 1024)); }
#pragma unroll
    for (int t = 0; t < 3; ++t) { int key = q0 - 128 + 64 * t + 16 * (wid & 3) + (lane >> 2); key = key < 0 ? 0 : key;
        glds16(Vb + (rowbase + key) * 256 + kvh * 64 + (wid >> 2) * 32 + (lane & 3) * 8, (unsigned)__builtin_amdgcn_readfirstlane(lds0 + VOFF + buf * UBYTES + t * 8192 + wid * 1024)); }
}

__device__ __forceinline__ void attn_phase(LAS unsigned char* ldsb, const bf16* Qb, const bf16* Kb, const bf16* Vb, const bf16* SGb, bf16* OGb, const float* sinks, int vcu, int G) {
    int tid_ = threadIdx.x; asm volatile("" : "+v"(tid_));
    const int tid = tid_, lane = tid & 63, r32 = lane & 31, hi = lane >> 5; const int wid = __builtin_amdgcn_readfirstlane(tid >> 6);
    const int j = wid & 1, hq = wid >> 1;
    const unsigned lds0 = (unsigned)(uintptr_t)ldsb;
    LAS float* wsf = (LAS float*)(ldsb + WSFOFF) + wid * 64;
    LAS bf16* stg = (LAS bf16*)(ldsb + OSTOFF) + wid * 2048;
    const int nunits = BATCH * 4 * (SEQ / 64);
    const int per = nunits / G;
    const int uid0 = vcu * per;
    bf16x8 qn[4];
    {   const int uid = uid0; const int b = uid >> 8, kvh = (uid >> 6) & 3, qb = uid & 63; const bf16* Qw = Qb + ((long)b * SEQ + qb * 64 + 32 * j + r32) * DM + (kvh * 4 + hq) * 64;
#pragma unroll
        for (int d0 = 0; d0 < 4; ++d0) qn[d0] = *(const bf16x8*)(Qw + d0 * 16 + hi * 8);
        dma_unit(Kb, Vb, uid, 0, lds0, wid, lane); }
    for (int i = 0; i < per; ++i) {
        const int uid = uid0 + i, buf = i & 1;
        const int b = uid >> 8, kvh = (uid >> 6) & 3, qb = uid & 63, q0 = qb * 64, h = kvh * 4 + hq; const long rowbase = (long)b * SEQ;
        bf16x8 qr[4];
        asm volatile("s_waitcnt vmcnt(0)" : "+v"(qn[0]), "+v"(qn[1]), "+v"(qn[2]), "+v"(qn[3]) :: "memory");
#pragma unroll
        for (int d0 = 0; d0 < 4; ++d0) qr[d0] = qn[d0];
        asm volatile("s_waitcnt lgkmcnt(0)\n\ts_barrier" ::: "memory");
        if (i + 1 < per) {
            const int u2 = uid + 1; dma_unit(Kb, Vb, u2, buf ^ 1, lds0, wid, lane);
            const int b2 = u2 >> 8, kvh2 = (u2 >> 6) & 3, qb2 = u2 & 63; const bf16* Qw = Qb + ((long)b2 * SEQ + qb2 * 64 + 32 * j + r32) * DM + (kvh2 * 4 + hq) * 64;
#pragma unroll
            for (int d0 = 0; d0 < 4; ++d0) qn[d0] = *(const bf16x8*)(Qw + d0 * 16 + hi * 8);
        }
        const lds_cptr kp = (lds_cptr)ldsb + KOFF + buf * UBYTES + hi * 1024 + r32 * 16;
        f32x16 S[5];
#pragma unroll
        for (int ii = 0; ii < 5; ++ii) { const int kb = j + ii; const lds_cptr p = kp + (kb >> 1) * 8192 + (kb & 1) * 512;
            f32x16 a = f32x16{};
#pragma unroll
            for (int d0 = 0; d0 < 4; ++d0) { const bf16x8 kf = *(const LAS bf16x8*)(p + d0 * 2048); a = __builtin_amdgcn_mfma_f32_32x32x16_bf16(kf, qr[d0], a, 0, 0, 0); }
            S[ii] = a; }
        const float NEG = -INFINITY;
#pragma unroll
        for (int r = 0; r < 16; ++r) { const int c = (r & 3) + 8 * (r >> 2) + 4 * hi; if (!(c > r32)) S[0][r] = NEG; if (!(c <= r32)) S[4][r] = NEG; }
        if (q0 < 128) {
#pragma unroll
            for (int ii = 0; ii < 4; ++ii)
#pragma unroll
                for (int r = 0; r < 16; ++r) { const int c = (r & 3) + 8 * (r >> 2) + 4 * hi; if (q0 - 128 + 32 * (j + ii) + c < 0) S[ii][r] = NEG; }
        }
        const float sink2 = sinks[h] * LOG2E;
        float mx = sink2;
#pragma unroll
        for (int ii = 0; ii < 5; ++ii)
#pragma unroll
            for (int r = 0; r < 16; ++r) mx = __builtin_fmaxf(mx, S[ii][r]);
        { auto rr = __builtin_amdgcn_permlane32_swap(__float_as_uint(mx), __float_as_uint(mx), false, false); mx = __builtin_fmaxf(__uint_as_float(rr[0]), __uint_as_float(rr[1])); }
        float l = 0.f;
#pragma unroll
        for (int ii = 0; ii < 5; ++ii)
#pragma unroll
            for (int r = 0; r < 16; ++r) { const float p = __builtin_amdgcn_exp2f(S[ii][r] - mx); S[ii][r] = p; l += p; }
        { auto rr = __builtin_amdgcn_permlane32_swap(__float_as_uint(l), __float_as_uint(l), false, false); l = __uint_as_float(rr[0]) + __uint_as_float(rr[1]); }
        l += __builtin_amdgcn_exp2f(sink2 - mx);
        if (hi == 0) wsf[32 + r32] = __builtin_amdgcn_rcpf(l);
        f32x16 o[2]; o[0] = f32x16{}; o[1] = f32x16{};
        const lds_cptr vp = (lds_cptr)ldsb + VOFF + buf * UBYTES + ((lane >> 4) & 1) * 32 + (lane & 3) * 8 + (4 * hi + ((lane & 15) >> 2)) * 64;
#pragma unroll
        for (int ii = 0; ii < 5; ++ii) { const int kb = j + ii; const lds_cptr vt = vp + (kb >> 1) * 8192 + (kb & 1) * 2048;
#pragma unroll
            for (int s = 0; s < 2; ++s) {
                v4u pw; pw.x = cvtpk(S[ii][8 * s + 0], S[ii][8 * s + 1]); pw.y = cvtpk(S[ii][8 * s + 2], S[ii][8 * s + 3]); pw.z = cvtpk(S[ii][8 * s + 4], S[ii][8 * s + 5]); pw.w = cvtpk(S[ii][8 * s + 6], S[ii][8 * s + 7]);
                const bf16x8 pa = __builtin_bit_cast(bf16x8, pw);
#pragma unroll
                for (int d0 = 0; d0 < 2; ++d0) { const s16x4 lo = vtr(vt + d0 * 4096 + s * 1024), hh = vtr(vt + d0 * 4096 + s * 1024 + 512);
                    const bf16x8 vf = (bf16x8){lo[0], lo[1], lo[2], lo[3], hh[0], hh[1], hh[2], hh[3]};
                    o[d0] = __builtin_amdgcn_mfma_f32_32x32x16_bf16(pa, vf, o[d0], 0, 0, 0); }
            } }
        asm volatile("s_waitcnt lgkmcnt(0)" ::: "memory");
#pragma unroll
        for (int r = 0; r < 16; ++r) { const int orow = (r & 3) + 8 * (r >> 2) + 4 * hi; const float rl = wsf[32 + orow];
#pragma unroll
            for (int d0 = 0; d0 < 2; ++d0) stg[orow * 64 + d0 * 32 + r32] = (bf16)f2bf(o[d0][r] * rl); }
        asm volatile("s_waitcnt lgkmcnt(0)" ::: "memory");
        const size_t obase = (size_t)(rowbase + q0 + 32 * j) * DM + h * 64;
#pragma unroll
        for (int i4 = 0; i4 < 4; ++i4) { const int row = i4 * 8 + (lane >> 3), ch = lane & 7;
            const v4u ov = *(const LAS v4u*)(stg + row * 64 + ch * 8); const v4u gv = *(const v4u*)(SGb + obase + (size_t)row * DM + ch * 8);
            v4u w; w.x = cvtpk(bf_lo(ov.x) * bf_lo(gv.x), bf_hi(ov.x) * bf_hi(gv.x)); w.y = cvtpk(bf_lo(ov.y) * bf_lo(gv.y), bf_hi(ov.y) * bf_hi(gv.y));
            w.z = cvtpk(bf_lo(ov.z) * bf_lo(gv.z), bf_hi(ov.z) * bf_hi(gv.z)); w.w = cvtpk(bf_lo(ov.w) * bf_lo(gv.w), bf_hi(ov.w) * bf_hi(gv.w));
            *(v4u*)(OGb + obase + (size_t)row * DM + ch * 8) = w; }
    }
    asm volatile("s_waitcnt vmcnt(0) lgkmcnt(0)\n\ts_barrier" ::: "memory");
}
}


__device__ __forceinline__ void attn_brute(const bf16* Qb, const bf16* Kb, const bf16* Vb, const bf16* SGb, bf16* OGb, const float* sinks, int vcu, int G, int tid) {
    const int gt = vcu * (NWAVES * 64) + tid, NT = G * NWAVES * 64;
    for (int it = gt; it < M * 16; it += NT) {
        const int m = it >> 4, h = it & 15, kvh = h >> 2, pos = m & (SEQ - 1);
        float q[64], o[64];
        const v4u* qp = (const v4u*)(Qb + (size_t)m * DM + h * 64);
#pragma unroll
        for (int c = 0; c < 8; ++c) { const v4u w = qp[c]; q[8*c+0] = bf_lo(w.x); q[8*c+1] = bf_hi(w.x); q[8*c+2] = bf_lo(w.y); q[8*c+3] = bf_hi(w.y); q[8*c+4] = bf_lo(w.z); q[8*c+5] = bf_hi(w.z); q[8*c+6] = bf_lo(w.w); q[8*c+7] = bf_hi(w.w); }
#pragma unroll
        for (int d = 0; d < 64; ++d) o[d] = 0.f;
        float mx = sinks[h] * LOG2E, l = 1.0f;
        const int nk = pos < 127 ? pos + 1 : 128;
        for (int jk = 0; jk < nk; ++jk) {
            const size_t kr = (size_t)(m - jk) * 256 + kvh * 64;
            const v4u* kp = (const v4u*)(Kb + kr); float sc = 0.f;
#pragma unroll
            for (int c = 0; c < 8; ++c) { const v4u w = kp[c]; sc += q[8*c+0] * bf_lo(w.x) + q[8*c+1] * bf_hi(w.x) + q[8*c+2] * bf_lo(w.y) + q[8*c+3] * bf_hi(w.y) + q[8*c+4] * bf_lo(w.z) + q[8*c+5] * bf_hi(w.z) + q[8*c+6] * bf_lo(w.w) + q[8*c+7] * bf_hi(w.w); }
            const float mn = __builtin_fmaxf(mx, sc), f = __builtin_amdgcn_exp2f(mx - mn), p = __builtin_amdgcn_exp2f(sc - mn);
            l = l * f + p; mx = mn;
            const v4u* vp = (const v4u*)(Vb + kr);
#pragma unroll
            for (int c = 0; c < 8; ++c) { const v4u w = vp[c];
                o[8*c+0] = o[8*c+0] * f + p * bf_lo(w.x); o[8*c+1] = o[8*c+1] * f + p * bf_hi(w.x); o[8*c+2] = o[8*c+2] * f + p * bf_lo(w.y); o[8*c+3] = o[8*c+3] * f + p * bf_hi(w.y);
                o[8*c+4] = o[8*c+4] * f + p * bf_lo(w.z); o[8*c+5] = o[8*c+5] * f + p * bf_hi(w.z); o[8*c+6] = o[8*c+6] * f + p * bf_lo(w.w); o[8*c+7] = o[8*c+7] * f + p * bf_hi(w.w); }
        }
        const float rl = 1.0f / l;
        const v4u* gp = (const v4u*)(SGb + (size_t)m * DM + h * 64); v4u* op = (v4u*)(OGb + (size_t)m * DM + h * 64);
#pragma unroll
        for (int c = 0; c < 8; ++c) { const v4u g = gp[c]; v4u w;
            w.x = pk2(o[8*c+0] * rl * bf_lo(g.x), o[8*c+1] * rl * bf_hi(g.x)); w.y = pk2(o[8*c+2] * rl * bf_lo(g.y), o[8*c+3] * rl * bf_hi(g.y));
            w.z = pk2(o[8*c+4] * rl * bf_lo(g.z), o[8*c+5] * rl * bf_hi(g.z)); w.w = pk2(o[8*c+6] * rl * bf_lo(g.w), o[8*c+7] * rl * bf_hi(g.w)); op[c] = w; }
    }
}

#define FRAME_MARK
struct Args {
    const float* x; const float* c; const int* pos; const float* ada_w; const float* ada_b; const float* norm_g;
    const float* a_win; const float* a_qn; const float* a_kn; const float* a_sink; const float* a_wout;
    const float* p_win; const float* p_wg; const float* p_scale; const float* p_wout;
    float* out; unsigned char* ws; int ph_lo, ph_hi;
};


__device__ void brute_attn_in(const Args& A, int jl, int layer, int vcu, int G, int tid) {
    unsigned char* ws = A.ws; const float* mod = (const float*)(ws + WS_MOD) + (size_t)layer * 4 * MODW;
    const float* X = layer == 0 ? A.x : A.out; const float* W = A.a_win + (size_t)jl * DM * NAIN; const float* ng = A.norm_g + (size_t)layer * DM;
    bf16* Qo = (bf16*)(ws + WS_Q); bf16* Ko = (bf16*)(ws + WS_K); bf16* Vo = (bf16*)(ws + WS_V); bf16* So = (bf16*)(ws + WS_SG);
    const float* rc = (const float*)(ws + WS_ROPE); const float* rsn = rc + (size_t)M * 8;
    const int gt = vcu * (NWAVES * 64) + tid, NT = G * NWAVES * 64;
    for (int it = gt; it < M * 40; it += NT) {
        const int c40 = it / M, m = it % M, b = m >> 12;
        const float* xr = X + (size_t)m * DM; const float* sh = mod + (size_t)b * MODW; const float* sc = sh + DM;
        float ss = 0.f; for (int k = 0; k < DM; ++k) ss += xr[k] * xr[k];
        const float rstd = 1.0f / sqrtf(ss * (1.0f / DM) + NORM_EPS);
        float acc[64];
#pragma unroll
        for (int d = 0; d < 64; ++d) acc[d] = 0.f;
        for (int k = 0; k < DM; ++k) {
            const float h = xr[k] * rstd * ng[k] * (1.0f + sc[k]) + sh[k];
            const f32x4* wp = (const f32x4*)(W + (size_t)k * NAIN + c40 * 64);
#pragma unroll
            for (int c = 0; c < 16; ++c) { const f32x4 w = wp[c]; acc[4*c] += h * w[0]; acc[4*c+1] += h * w[1]; acc[4*c+2] += h * w[2]; acc[4*c+3] += h * w[3]; }
        }
        if (c40 < 20) {
            const float* g = (c40 < 16) ? (A.a_qn + jl * 64) : (A.a_kn + jl * 64);
            float q2 = 0.f;
#pragma unroll
            for (int d = 0; d < 64; ++d) q2 += acc[d] * acc[d];
            const float rq = 1.0f / sqrtf(q2 * (1.0f / 64.0f) + NORM_EPS);
#pragma unroll
            for (int d = 0; d < 64; ++d) acc[d] = acc[d] * rq * g[d];
#pragma unroll
            for (int i = 0; i < 8; ++i) { const float cs = rc[(size_t)m * 8 + i], sn = rsn[(size_t)m * 8 + i]; const float x1 = acc[i], x2 = acc[8 + i]; acc[i] = x1 * cs - x2 * sn; acc[8 + i] = x2 * cs + x1 * sn; }
            const float osc = (c40 < 16) ? C2 : 1.0f;
            bf16* o = (c40 < 16) ? (Qo + (size_t)m * DM + c40 * 64) : (Ko + (size_t)m * 256 + (c40 - 16) * 64);
#pragma unroll
            for (int d = 0; d < 64; d += 2) *(unsigned*)(o + d) = pk2(acc[d] * osc, acc[d + 1] * osc);
        } else if (c40 < 24) {
            bf16* o = Vo + (size_t)m * 256 + (c40 - 20) * 64;
#pragma unroll
            for (int d = 0; d < 64; d += 2) *(unsigned*)(o + d) = pk2(acc[d], acc[d + 1]);
        } else {
            bf16* o = So + (size_t)m * DM + (c40 - 24) * 64;
#pragma unroll
            for (int d = 0; d < 64; d += 2) *(unsigned*)(o + d) = pk2(silu_f(acc[d]), silu_f(acc[d + 1]));
        }
    }
}


__device__ void brute_pool_a(const Args& A, int jl, int layer, int vcu, int G, int tid, size_t voff) {
    unsigned char* ws = A.ws; const float* mod = (const float*)(ws + WS_MOD) + (size_t)layer * 4 * MODW;
    const float* X = layer == 0 ? A.x : A.out; const float* W = A.p_win + (size_t)jl * DM * NPIN; const float* ng = A.norm_g + (size_t)layer * DM;
    float* Vf = (float*)(ws + voff); bf16* So = (bf16*)(ws + WS_SG);
    const int gt = vcu * (NWAVES * 64) + tid, NT = G * NWAVES * 64;
    for (int it = gt; it < M * 32; it += NT) {
        const int c32 = it / M, m = it % M, b = m >> 12;
        const float* xr = X + (size_t)m * DM; const float* sh = mod + (size_t)b * MODW; const float* sc = sh + DM;
        float ss = 0.f; for (int k = 0; k < DM; ++k) ss += xr[k] * xr[k];
        const float rstd = 1.0f / sqrtf(ss * (1.0f / DM) + NORM_EPS);
        float acc[64];
#pragma unroll
        for (int d = 0; d < 64; ++d) acc[d] = 0.f;
        for (int k = 0; k < DM; ++k) {
            const float h = xr[k] * rstd * ng[k] * (1.0f + sc[k]) + sh[k];
            const f32x4* wp = (const f32x4*)(W + (size_t)k * NPIN + c32 * 64);
#pragma unroll
            for (int c = 0; c < 16; ++c) { const f32x4 w = wp[c]; acc[4*c] += h * w[0]; acc[4*c+1] += h * w[1]; acc[4*c+2] += h * w[2]; acc[4*c+3] += h * w[3]; }
        }
        if (c32 < 16) { float* o = Vf + (size_t)m * DM + c32 * 64;
#pragma unroll
            for (int d = 0; d < 64; ++d) o[d] = acc[d]; }
        else { bf16* o = So + (size_t)m * DM + (c32 - 16) * 64;
#pragma unroll
            for (int d = 0; d < 64; d += 2) *(unsigned*)(o + d) = pk2(silu_f(acc[d]), silu_f(acc[d + 1])); }
    }
}
__device__ void brute_pool_b(const Args& A, int jl, int vcu, int G, int tid, size_t voff) {
    unsigned char* ws = A.ws; const float* Vf = (const float*)(ws + voff); bf16* So = (bf16*)(ws + WS_SG);
    const int gt = vcu * (NWAVES * 64) + tid, NT = G * NWAVES * 64;
    for (int it = gt; it < M * 16; it += NT) {
        const int c16 = it / M, m = it % M, grp = c16 >> 2, d0 = (c16 & 3) * 64, w = 2 << grp, pos = m & (SEQ - 1);
        const int cnt = (pos + 1 < w) ? pos + 1 : w;
        const float* Wg = A.p_wg + ((size_t)jl * 4 + grp) * 65536;
        float acc[64];
#pragma unroll
        for (int d = 0; d < 64; ++d) acc[d] = 0.f;
        for (int c = 0; c < 256; ++c) {
            float sm = 0.f; for (int jj = 0; jj < cnt; ++jj) sm += Vf[(size_t)(m - jj) * DM + grp * 256 + c];
            const float p = sm / (float)cnt - Vf[(size_t)m * DM + grp * 256 + c];
            const f32x4* wp = (const f32x4*)(Wg + (size_t)c * 256 + d0);
#pragma unroll
            for (int q = 0; q < 16; ++q) { const f32x4 wv = wp[q]; acc[4*q] += p * wv[0]; acc[4*q+1] += p * wv[1]; acc[4*q+2] += p * wv[2]; acc[4*q+3] += p * wv[3]; }
        }
        const float* scl = A.p_scale + (size_t)jl * DM + grp * 256 + d0; bf16* o = So + (size_t)m * DM + grp * 256 + d0;
#pragma unroll
        for (int d = 0; d < 64; d += 2) { const unsigned g = *(const unsigned*)(o + d); *(unsigned*)(o + d) = pk2(acc[d] * scl[d] * bf_lo(g), acc[d + 1] * scl[d + 1] * bf_hi(g)); }
    }
}

__device__ __forceinline__ float wave_sum(float v) {
#pragma unroll
    for (int o = 1; o < 64; o <<= 1) v += __shfl_xor(v, o);
    return v;
}
__device__ __forceinline__ int attn_dst_row(int n) {
    const int tile = n >> 8, c = n & 255, wc = c >> 6, d = c & 63;
    int dp = d;
    if (tile < 5 && d < 16) dp = 8 * ((d >> 2) & 1) + 4 * (d >> 3) + (d & 3);
    return tile * 256 + 128 * (dp >> 5) + 32 * wc + (dp & 31);
}
__device__ __forceinline__ void transpose_item(const float* W, int ldw, int ncol0, int K, int nblk, bf16* WT, int row_off, int mode, LAS float* scr, int item, int lane) {
    const int kb = item / nblk, nb = item % nblk, k0 = 64 * kb, n0 = 32 * nb;
    {   const int kk8 = lane >> 3, c4 = lane & 7;
        f32x4 v[8];
#pragma unroll
        for (int i = 0; i < 8; ++i) v[i] = *(const f32x4*)(W + (size_t)(k0 + 8 * i + kk8) * ldw + ncol0 + n0 + 4 * c4);
#pragma unroll
        for (int i = 0; i < 8; ++i) { LAS float* d = scr + (8 * i + kk8) * 33 + 4 * c4; d[0] = v[i][0]; d[1] = v[i][1]; d[2] = v[i][2]; d[3] = v[i][3]; }
    }
    LDS_WAIT(); asm volatile("" ::: "memory");
    const int c = lane & 7;
#pragma unroll
    for (int jj = 0; jj < 4; ++jj) { const int n = (lane >> 3) + 8 * jj; const LAS float* s = scr + (8 * c) * 33 + n;
        v4u o; o.x = pk2(s[0 * 33], s[1 * 33]); o.y = pk2(s[2 * 33], s[3 * 33]); o.z = pk2(s[4 * 33], s[5 * 33]); o.w = pk2(s[6 * 33], s[7 * 33]);
        const int drow = mode ? attn_dst_row(n0 + n) : (n0 + n);
        *(GAS v4u*)(WT + (size_t)(row_off + drow) * K + k0 + 8 * c) = o; }
    LDS_WAIT(); asm volatile("" ::: "memory");
}


__device__ void brute_out(const Args& A, const bf16* Aop, const float* W, int layer, int vcu, int G, int tid) {
    unsigned char* ws = A.ws; const float* gate = (const float*)(ws + WS_MOD) + (size_t)layer * 4 * MODW + 2 * DM;
    const float* X = layer == 0 ? A.x : A.out;
    const int gt = vcu * (NWAVES * 64) + tid, NT = G * NWAVES * 64;
    for (int it = gt; it < M * 16; it += NT) {
        const int c16 = it / M, m = it % M, b = m >> 12;
        float acc[64];
#pragma unroll
        for (int d = 0; d < 64; ++d) acc[d] = 0.f;
        const bf16* ar = Aop + (size_t)m * DM;
        for (int k = 0; k < DM; k += 2) {
            const unsigned a2 = *(const unsigned*)(ar + k); const float a0 = bf_lo(a2), a1 = bf_hi(a2);
            const f32x4* w0 = (const f32x4*)(W + (size_t)k * DM + c16 * 64); const f32x4* w1 = (const f32x4*)(W + (size_t)(k + 1) * DM + c16 * 64);
#pragma unroll
            for (int c = 0; c < 16; ++c) { const f32x4 u = w0[c], v = w1[c]; acc[4*c] += a0 * u[0] + a1 * v[0]; acc[4*c+1] += a0 * u[1] + a1 * v[1]; acc[4*c+2] += a0 * u[2] + a1 * v[2]; acc[4*c+3] += a0 * u[3] + a1 * v[3]; }
        }
        const float* xr = X + (size_t)m * DM + c16 * 64; float* xo = A.out + (size_t)m * DM + c16 * 64; const float* gp = gate + (size_t)b * MODW + c16 * 64;
#pragma unroll
        for (int d = 0; d < 64; ++d) xo[d] = xr[d] + gp[d] * acc[d];
    }
}
__device__ void brute_xb(const Args& A, int layer_next, int vcu, int G, int lane, int wave) {
    unsigned char* ws = A.ws; const float* mod = (const float*)(ws + WS_MOD) + (size_t)layer_next * 4 * MODW;
    const int gw = vcu * NWAVES + wave, NGW = G * NWAVES;
    float* rowss = (float*)(ws + WS_ROWSS); bf16* xb = (bf16*)(ws + WS_XB);
    for (int m = gw; m < M; m += NGW) {
        const int b = m >> 12; const float* scl = mod + (size_t)b * MODW + DM;
        const GAS f32x4* xr = (const GAS f32x4*)(A.out + (size_t)m * DM) + lane;
        GAS unsigned long long* o8 = (GAS unsigned long long*)(xb + (size_t)m * DM) + lane;
        float s = 0.f;
#pragma unroll
        for (int jj = 0; jj < 4; ++jj) { const f32x4 v = xr[64 * jj]; s += (v.x * v.x + v.y * v.y) + (v.z * v.z + v.w * v.w);
            const f32x4 g = *(const f32x4*)(A.norm_g + (size_t)layer_next * DM + 256 * jj + 4 * lane), sc = *(const f32x4*)(scl + 256 * jj + 4 * lane); const f32x4 y = v * g * (sc + 1.0f);
            o8[64 * jj] = (unsigned long long)pk2(y.x, y.y) | ((unsigned long long)pk2(y.z, y.w) << 32); }
        s = wave_sum(s);
        if (lane == 0) { rowss[m] = s; rowss[M + m] = 0.f; rowss[2 * M + m] = 0.f; rowss[3 * M + m] = 0.f; }
    }
}


__device__ void brute_mod(const Args& A, int vcu, int G, int tid) {
    float* mod = (float*)(A.ws + WS_MOD);
    const int gt = vcu * (NWAVES * 64) + tid, NT = G * NWAVES * 64;
    for (int it = gt; it < DEPTH * 4 * MODW; it += NT) {
        const int j = it % MODW, b = (it / MODW) & 3, l = it / (4 * MODW);
        double acc = 0.0;
        for (int k = 0; k < DM; ++k) { const double cv = (double)A.c[b * DM + k]; const double sv = cv / (1.0 + (double)expf(-(float)cv)); acc += sv * (double)A.ada_w[((size_t)l * DM + k) * MODW + j]; }
        mod[it] = (float)(acc + (double)A.ada_b[l * MODW + j]);
    }
}

__device__ __forceinline__ void gemv64_item(const float* W, int ldw, const LAS f32x4* vec, LAS float* red, const float* bias, float* out, int out_ld, int tid, int lane, int wave) {
    const int kk = lane >> 4, c4 = lane & 15;
    const float* wp = W + (size_t)(wave * 128 + kk) * ldw + 4 * c4;
    f32x4 ac[4]; ac[0] = ac[1] = ac[2] = ac[3] = (f32x4){0.f, 0.f, 0.f, 0.f};
#pragma unroll 16
    for (int i = 0; i < 32; ++i) { const f32x4 w = *(const f32x4*)(wp + (size_t)(4 * i) * ldw); const f32x4 s = vec[wave * 128 + 4 * i + kk];
        ac[0] += w * s.x; ac[1] += w * s.y; ac[2] += w * s.z; ac[3] += w * s.w; }
#pragma unroll
    for (int bb = 0; bb < 4; ++bb)
#pragma unroll
        for (int e = 0; e < 4; ++e) { float v = ac[bb][e]; v += __shfl_xor(v, 16); v += __shfl_xor(v, 32); ac[bb][e] = v; }
    if (kk == 0) {
#pragma unroll
        for (int bb = 0; bb < 4; ++bb) *(LAS f32x4*)(red + (wave * 4 + bb) * 64 + 4 * c4) = ac[bb]; }
    __syncthreads();
    if (tid < 256) { const int bb = tid >> 6, col = tid & 63; float s = 0.f;
#pragma unroll
        for (int w = 0; w < 8; ++w) s += red[(w * 4 + bb) * 64 + col];
        out[(size_t)bb * out_ld + col] = s + (bias ? bias[col] : 0.f); }
    __syncthreads();
}

__device__ __forceinline__ void phase_p0a(const Args& A, LAS unsigned char* lds, int vcu, int G, int tid, int lane, int wave) {
    unsigned char* ws = A.ws;
    {
        LAS f32x4* sc = (LAS f32x4*)lds;
        LAS float* red = (LAS float*)(lds + 16384);
        if (vcu < DEPTH * 48) { for (int k = tid; k < DM; k += NWAVES * 64) { f32x4 v; v.x = silu_f(A.c[k]); v.y = silu_f(A.c[DM + k]); v.z = silu_f(A.c[2 * DM + k]); v.w = silu_f(A.c[3 * DM + k]); sc[k] = v; } }
        __syncthreads();
        for (int it = vcu; it < DEPTH * 48; it += G) {
            const int l = it / 48, jb = it % 48;
            gemv64_item(A.ada_w + (size_t)l * DM * MODW + jb * 64, MODW, sc, red, A.ada_b + l * MODW + jb * 64, (float*)(ws + WS_MOD) + (size_t)l * 4 * MODW + jb * 64, MODW, tid, lane, wave);
        }
    }
    LAS float* scr = (LAS float*)(lds + 32768 + wave * 8704);
    const int gw = vcu * NWAVES + wave, NGW = G * NWAVES;
    constexpr int I_AIN = 16 * 80, I_PG = 16 * 32, I_OUT = 16 * 32, I_WG = 4 * 8;
    constexpr int T0 = 2 * I_AIN, T1 = T0 + 2 * I_PG, T2 = T1 + 2 * I_OUT, T3 = T2 + 2 * I_OUT, T4 = T3 + 8 * I_WG, T5 = T4 + (2 * DM) / 2, T6 = T5 + (M * 8) / 64;
    for (int it = gw; it < T6; it += NGW) {
        if (it < T0) { const int l = it / I_AIN, r = it % I_AIN; transpose_item(A.a_win + (size_t)l * DM * NAIN, NAIN, 0, DM, 80, (bf16*)(ws + WS_WAIN) + (size_t)l * NAIN * DM, 0, 1, scr, r, lane); }
        else if (it < T1) { const int q = it - T0, l = q / I_PG, r = q % I_PG; transpose_item(A.p_win + (size_t)l * DM * NPIN, NPIN, DM, DM, 32, (bf16*)(ws + WS_WPIN) + (size_t)l * NPIN * DM, DM, 0, scr, r, lane); }
        else if (it < T2) { const int q = it - T1, l = q / I_OUT, r = q % I_OUT; transpose_item(A.a_wout + (size_t)l * DM * DM, DM, 0, DM, 32, (bf16*)(ws + WS_WAOUT) + (size_t)l * DM * DM, 0, 0, scr, r, lane); }
        else if (it < T3) { const int q = it - T2, l = q / I_OUT, r = q % I_OUT; transpose_item(A.p_wout + (size_t)l * DM * DM, DM, 0, DM, 32, (bf16*)(ws + WS_WPOUT) + (size_t)l * DM * DM, 0, 0, scr, r, lane); }
        else if (it < T4) { const int q = it - T3, lg = q / I_WG, r = q % I_WG;
            transpose_item(A.p_wg + (size_t)lg * 65536, 256, 0, 256, 8, (bf16*)(ws + WS_CA) + (size_t)lg * 65536, 0, 0, scr, r, lane); }
        else if (it < T5) { const int q = 2 * (it - T4), l = q / DM, k = q % DM;
            const float* src = A.p_win + ((size_t)l * DM + k) * NPIN; bf16* dst = (bf16*)(ws + WS_CB) + (size_t)l * 4 * DM * 256 + (size_t)k * 256;
            f32x4 v[2][4];
#pragma unroll
            for (int r = 0; r < 2; ++r)
#pragma unroll
                for (int g = 0; g < 4; ++g) v[r][g] = *(const f32x4*)(src + (size_t)r * NPIN + g * 256 + 4 * lane);
#pragma unroll
            for (int r = 0; r < 2; ++r)
#pragma unroll
                for (int g = 0; g < 4; ++g) { v2u o; o.x = pk2(v[r][g][0], v[r][g][1]); o.y = pk2(v[r][g][2], v[r][g][3]); *(v2u*)(dst + (size_t)g * DM * 256 + (size_t)r * 256 + 4 * lane) = o; } }
        else { const int q = (it - T5) * 64 + lane; const int m = q >> 3, i = q & 7;
            const float invf[8] = {1.0f, 0.1939227432012558f, 0.03760603070259094f, 0.007292664609849453f, 0.0014142135623842478f, 0.00027424818836152554f, 5.318296098266728e-05f, 1.0313386155758053e-05f};
            float fr_ = invf[0];
#pragma unroll
            for (int e = 1; e < 8; ++e) fr_ = (i == e) ? invf[e] : fr_;
            const float ang = (float)A.pos[m] * fr_;
            const double a = (double)ang; const double kq = __builtin_rint(a * 0.63661977236758134308);
            double y = __builtin_fma(-kq, 1.57079632679489655800, a); y = __builtin_fma(-kq, 6.12323399573676603587e-17, y);
            const double y2 = y * y;
            double sp = -2.5052108385441718775e-08; sp = sp * y2 + 2.7557319223985890653e-06; sp = sp * y2 - 1.9841269841269841253e-04; sp = sp * y2 + 8.3333333333333332177e-03; sp = sp * y2 - 1.6666666666666665741e-01; const double sn = y + y * y2 * sp;
            double cp = 2.0876756987868098979e-09; cp = cp * y2 - 2.7557319223985888276e-07; cp = cp * y2 + 2.4801587301587301566e-05; cp = cp * y2 - 1.3888888888888889419e-03; cp = cp * y2 + 4.1666666666666664354e-02; cp = cp * y2 - 0.5; const double cs = 1.0 + y2 * cp;
            const int qd = ((int)(long long)kq) & 3;
            const double s_ = (qd == 0) ? sn : (qd == 1) ? cs : (qd == 2) ? -sn : -cs;
            const double c_ = (qd == 0) ? cs : (qd == 1) ? -sn : (qd == 2) ? -cs : sn;
            ((float*)(ws + WS_ROPE))[q] = (float)c_; ((float*)(ws + WS_ROPE))[(size_t)M * 8 + q] = (float)s_; }
    }
}

__device__ __forceinline__ void phase_p0b(const Args& A, LAS unsigned char* lds, int vcu, int G, int tid, int lane, int wave) {
    unsigned char* ws = A.ws;
    const float* mod = (const float*)(ws + WS_MOD);
    {
        pg8::Gemm g{(const bf16*)(ws + WS_CA), (const bf16*)(ws + WS_CB), 2048, DM, 256, 0, (size_t)DM * 256 * 2}; pg8::StaticOrder S; S.init(2048, DM, G, (int)blockIdx.x);
        pg8::EpiComb E{(bf16*)(ws + WS_WPIN)};
        pg8::gemm_phase<pg8::EpiComb, pg8::StaticOrder, false, true>(lds, g, S, E);
    }
    __syncthreads();
    {
        LAS f32x4* sh = (LAS f32x4*)lds; LAS float* red = (LAS float*)(lds + 16384);
        const int bxs = (int)blockIdx.x - 32;
        for (int it = bxs; it >= 0 && it < 112; it += G) {
            int mat, nb; if (it < 80) { mat = it / 40; nb = it % 40; } else { mat = 2 + (it - 80) / 16; nb = (it - 80) % 16; }
            const int layer = (mat < 2) ? 2 * mat : 2 * (mat - 2) + 1;
            const float* shp = mod + (size_t)layer * 4 * MODW;
            __syncthreads();
            for (int k = tid; k < DM; k += NWAVES * 64) { f32x4 v; v.x = shp[k]; v.y = shp[MODW + k]; v.z = shp[2 * MODW + k]; v.w = shp[3 * MODW + k]; sh[k] = v; }
            __syncthreads();
            if (mat < 2) gemv64_item(A.a_win + (size_t)mat * DM * NAIN + nb * 64, NAIN, sh, red, nullptr, (float*)(ws + WS_SBA) + (size_t)mat * 4 * NAIN + nb * 64, NAIN, tid, lane, wave);
            else gemv64_item(A.p_win + (size_t)(mat - 2) * DM * NPIN + DM + nb * 64, NPIN, sh, red, nullptr, (float*)(ws + WS_SBP) + (size_t)(mat - 2) * 4 * DM + nb * 64, DM, tid, lane, wave);
        }
        __syncthreads();
    }
    {
        const int gw = vcu * NWAVES + wave, NGW = G * NWAVES;
        float* rowss = (float*)(ws + WS_ROWSS); bf16* xb = (bf16*)(ws + WS_XB);
        for (int m0 = 2 * gw; m0 < M; m0 += 2 * NGW) {
            const int b = m0 >> 12; const float* scl = mod + (size_t)b * MODW + DM;
            f32x4 v[2][4];
#pragma unroll
            for (int r = 0; r < 2; ++r)
#pragma unroll
                for (int jj = 0; jj < 4; ++jj) v[r][jj] = ((const GAS f32x4*)(A.x + (size_t)(m0 + r) * DM) + lane)[64 * jj];
#pragma unroll
            for (int r = 0; r < 2; ++r) {
                GAS unsigned long long* o8 = (GAS unsigned long long*)(xb + (size_t)(m0 + r) * DM) + lane;
                float s = 0.f;
#pragma unroll
                for (int jj = 0; jj < 4; ++jj) { const f32x4 x4 = v[r][jj]; s += (x4.x * x4.x + x4.y * x4.y) + (x4.z * x4.z + x4.w * x4.w);
                    const f32x4 g = *(const f32x4*)(A.norm_g + 256 * jj + 4 * lane), sc = *(const f32x4*)(scl + 256 * jj + 4 * lane); const f32x4 y = x4 * g * (sc + 1.0f);
                    o8[64 * jj] = (unsigned long long)pk2(y.x, y.y) | ((unsigned long long)pk2(y.z, y.w) << 32); }
                s = wave_sum(s);
                if (lane == 0) { rowss[m0 + r] = s; rowss[M + m0 + r] = 0.f; rowss[2 * M + m0 + r] = 0.f; rowss[3 * M + m0 + r] = 0.f; }
            }
        }
    }
}

__device__ __forceinline__ void phase_pool(const Args& A, int lp, int vcu, int G, int lane, int wave, size_t out_off) {
    unsigned char* ws = A.ws; const bf16* U = (const bf16*)(ws + WS_Q); const bf16* SG = (const bf16*)(ws + WS_SG); bf16* OUT = (bf16*)(ws + out_off);
    const int gw = vcu * NWAVES + wave, NGW = G * NWAVES;
    for (int it = gw; it < (M / 32) * 4; it += NGW) {
        const int grp = it & 3, t0 = (it >> 2) * 32 + (lane >> 5) * 16, pos0 = t0 & (SEQ - 1), w = 2 << grp;
        const int col = grp * 256 + 8 * (lane & 31);
        const f32x4 scl0 = *(const f32x4*)(A.p_scale + (size_t)lp * DM + col), scl1 = *(const f32x4*)(A.p_scale + (size_t)lp * DM + col + 4);
        const bf16* up = U + (size_t)t0 * DM + col; const bf16* gp = SG + (size_t)t0 * DM + col; bf16* op = OUT + (size_t)t0 * DM + col;
        f32x4 S0 = (f32x4){0.f, 0.f, 0.f, 0.f}, S1 = S0;
        for (int jj = 1; jj < w; ++jj) if (pos0 - jj >= 0) { const v4u v = *(const v4u*)(up - (size_t)jj * DM); S0 += (f32x4){bf_lo(v.x), bf_hi(v.x), bf_lo(v.y), bf_hi(v.y)}; S1 += (f32x4){bf_lo(v.z), bf_hi(v.z), bf_lo(v.w), bf_hi(v.w)}; }
#pragma unroll 4
        for (int t = 0; t < 16; ++t) {
            const v4u uv = *(const v4u*)(up + (size_t)t * DM); const v4u gv = *(const v4u*)(gp + (size_t)t * DM);
            const f32x4 u0 = (f32x4){bf_lo(uv.x), bf_hi(uv.x), bf_lo(uv.y), bf_hi(uv.y)}, u1 = (f32x4){bf_lo(uv.z), bf_hi(uv.z), bf_lo(uv.w), bf_hi(uv.w)};
            S0 += u0; S1 += u1;
            const int pos = pos0 + t; const float inv = 1.0f / (float)((pos + 1 < w) ? (pos + 1) : w);
            const f32x4 o0 = (S0 * inv - u0) * scl0 * (f32x4){bf_lo(gv.x), bf_hi(gv.x), bf_lo(gv.y), bf_hi(gv.y)};
            const f32x4 o1 = (S1 * inv - u1) * scl1 * (f32x4){bf_lo(gv.z), bf_hi(gv.z), bf_lo(gv.w), bf_hi(gv.w)};
            v4u ov; ov.x = pk2(o0[0], o0[1]); ov.y = pk2(o0[2], o0[3]); ov.z = pk2(o1[0], o1[1]); ov.w = pk2(o1[2], o1[3]); *(v4u*)(op + (size_t)t * DM) = ov;
            if (pos - (w - 1) >= 0) { const v4u v = *(const v4u*)(up + ((long)t - (long)(w - 1)) * DM); S0 -= (f32x4){bf_lo(v.x), bf_hi(v.x), bf_lo(v.y), bf_hi(v.y)}; S1 -= (f32x4){bf_lo(v.z), bf_hi(v.z), bf_lo(v.w), bf_hi(v.w)}; }
        }
    }
}

constexpr int N_PHASES = 2 + 3 * DEPTH;
__global__ void __launch_bounds__(NWAVES * 64, 2) trunk_fwd(Args Aarg) {
    extern __shared__ __attribute__((aligned(16))) unsigned char lds_[];
    LAS unsigned char* lds = (LAS unsigned char*)lds_;
    volatile LAS unsigned* MISC = (volatile LAS unsigned*)(lds + LDSCTL_OFF);
    const int G = gridDim.x; const int bx = blockIdx.x; const int vcu = (G % 8 == 0) ? (bx % 8) * (G / 8) + bx / 8 : bx;
    { const int tid = threadIdx.x; for (int u = tid; u < (LDS_BYTES - LDSCTL_OFF) / 4; u += NWAVES * 64) ((LAS unsigned*)(lds + LDSCTL_OFF))[u] = 0u; }
    __syncthreads();
    const int ph_lo = Aarg.ph_lo, ph_hi = Aarg.ph_hi;
    XcdBarrier bar; bar.bar = (unsigned*)(Aarg.ws + WS_CTL) + CW_BAR; bar.x = 0; bar.st = nullptr;
    if (ph_hi - ph_lo > 1) bar = xcd_barrier_post((unsigned*)(Aarg.ws + WS_CTL) + CW_BAR, MISC + 8);

#ifndef DBG_MASK
#define DBG_MASK 0xff
#endif
#if defined(__HIP_DEVICE_COMPILE__)
#define LOAD_ARGS() const __attribute__((address_space(4))) Args* ap = (const __attribute__((address_space(4))) Args*)__builtin_amdgcn_kernarg_segment_ptr(); asm volatile("" : "+s"(ap)); const Args A = *ap; \
        int tidp = threadIdx.x; asm volatile("" : "+v"(tidp)); const int lanep = tidp & 63, wavep = __builtin_amdgcn_readfirstlane(tidp >> 6); (void)lanep; (void)wavep
#else
#define LOAD_ARGS() const Args A = Aarg; int tidp = threadIdx.x; const int lanep = tidp & 63, wavep = tidp >> 6; (void)lanep; (void)wavep
#endif
#define GRID_BAR() do { XcdBarrier b2 = bar; asm volatile("" : "+s"(b2.bar)); xcd_barrier(b2); } while (0)
#define PROLOGUE() do { \
    if (ph_lo <= 0 && 0 < ph_hi) { LOAD_ARGS(); phase_p0a(A, lds, vcu, G, tidp, lanep, wavep); if (PROBE == 13) { GRID_BAR(); brute_mod(A, vcu, G, tidp); } if (1 < ph_hi) GRID_BAR(); } \
    if (ph_lo <= 1 && 1 < ph_hi) { LOAD_ARGS(); phase_p0b(A, lds, vcu, G, tidp, lanep, wavep); if (2 < ph_hi) GRID_BAR(); } } while (0)
    PROLOGUE();
#if PROBE == 1
    PROLOGUE();
#endif
    for (int ph = (ph_lo > 2 ? ph_lo : 2); ph < ph_hi; ++ph) {
        LOAD_ARGS();
        unsigned char* ws = A.ws;
        const float* mod = (const float*)(ws + WS_MOD);
        float* rowss = (float*)(ws + WS_ROWSS);
        bf16* XB = (bf16*)(ws + WS_XB); bf16* QB = (bf16*)(ws + WS_Q); bf16* SGB = (bf16*)(ws + WS_SG); bf16* KB = (bf16*)(ws + WS_K); bf16* VB = (bf16*)(ws + WS_V);
        {
            const int l = (ph - 2) / 3, sub = (ph - 2) % 3, jl = l >> 1; const bool is_attn = (l & 1) == 0;
            constexpr size_t DUMMY = 160 * MiB;
            if (sub == 0) {
                for (int rep = 0; rep < ((PROBE == 6 && is_attn) || (PROBE == 7 && !is_attn) ? 2 : 1); ++rep) {
                if (is_attn && PROBE == 10) { brute_attn_in(A, jl, l, vcu, G, tidp); }
                else if (is_attn) {
                    pg8::Gemm g{XB, (const bf16*)(ws + WS_WAIN) + (size_t)jl * NAIN * DM, M, NAIN, DM, 30, 0}; pg8::StaticOrder S; S.init(M, NAIN, G, bx);
                    pg8::EpiAttnIn E{rowss, (const float*)(ws + WS_SBA) + (size_t)jl * 4 * NAIN, A.a_qn + jl * 64, A.a_kn + jl * 64, (const float*)(ws + WS_ROPE), (const float*)(ws + WS_ROPE) + (size_t)M * 8, QB, KB, VB, SGB};
                    pg8::gemm_phase<pg8::EpiAttnIn, pg8::StaticOrder, true, true>(lds, g, S, E);
                } else if (PROBE == 11) { brute_pool_a(A, jl, l, vcu, G, tidp, DUMMY);
                } else {
                    pg8::Gemm g{XB, (const bf16*)(ws + WS_WPIN) + (size_t)jl * NPIN * DM, M, NPIN, DM, 30, 0}; pg8::StaticOrder S; S.init(M, NPIN, G, bx);
                    pg8::EpiPoolIn E{rowss, (const float*)(ws + WS_SBP) + (size_t)jl * 4 * DM, QB, SGB, PROBE == 9 ? (float*)(ws + DUMMY) : nullptr};
                    pg8::gemm_phase<pg8::EpiPoolIn, pg8::StaticOrder, true, true>(lds, g, S, E);
                }
                if (PROBE == 6 || PROBE == 7) __syncthreads();
                }
                if (PROBE == 4) { for (int e = 0; e < 8; ++e) GRID_BAR(); }
            } else if (sub == 1) {
                if (is_attn) { if (PROBE == 2) { att::attn_phase(lds, QB, KB, VB, SGB, (bf16*)(ws + DUMMY), A.a_sink + jl * 16, vcu, G); __syncthreads(); }
                    if (PROBE == 8 || PROBE == 10) attn_brute(QB, KB, VB, SGB, QB, A.a_sink + jl * 16, vcu, G, tidp); else att::attn_phase(lds, QB, KB, VB, SGB, QB, A.a_sink + jl * 16, vcu, G); }
                else if (PROBE == 11) brute_pool_b(A, jl, vcu, G, tidp, DUMMY);
                else { if (PROBE == 3) phase_pool(A, jl, vcu, G, lanep, wavep, DUMMY); phase_pool(A, jl, vcu, G, lanep, wavep, WS_SG); }
            } else {
                const bf16* Aop = is_attn ? QB : SGB;
                const bf16* Wt = is_attn ? (const bf16*)(ws + WS_WAOUT) + (size_t)jl * DM * DM : (const bf16*)(ws + WS_WPOUT) + (size_t)jl * DM * DM;
                pg8::Gemm g{Aop, Wt, M, DM, DM, 30, 0}; pg8::StaticOrder S; S.init(M, DM, G, bx);
                const bool lastl = (l == DEPTH - 1);
                if (PROBE == 12) { brute_out(A, Aop, is_attn ? A.a_wout + (size_t)jl * DM * DM : A.p_wout + (size_t)jl * DM * DM, l, vcu, G, tidp); if (!lastl) { GRID_BAR(); brute_xb(A, l + 1, vcu, G, lanep, wavep); } }
                else {
                if (PROBE == 5) {
                    pg8::EpiOut E{l == 0 ? A.x : A.out, (float*)(ws + DUMMY), mod + (size_t)l * 4 * MODW + 2 * DM, lastl ? nullptr : A.norm_g + (size_t)(l + 1) * DM, lastl ? nullptr : mod + (size_t)(l + 1) * 4 * MODW + DM, lastl ? nullptr : (bf16*)(ws + DUMMY + 64 * MiB), (float*)(ws + DUMMY + 80 * MiB)};
                    pg8::gemm_phase<pg8::EpiOut, pg8::StaticOrder, false, true>(lds, g, S, E); __syncthreads();
                }
                pg8::EpiOut E{l == 0 ? A.x : A.out, A.out, mod + (size_t)l * 4 * MODW + 2 * DM, lastl ? nullptr : A.norm_g + (size_t)(l + 1) * DM, lastl ? nullptr : mod + (size_t)(l + 1) * 4 * MODW + DM, lastl ? nullptr : XB, rowss};
                pg8::gemm_phase<pg8::EpiOut, pg8::StaticOrder, false, true>(lds, g, S, E);
                }
            }
        }
        if (ph + 1 < ph_hi) GRID_BAR();
    }
}

extern "C" void kernel_launch(void* const* d_in, const int* in_sizes, int n_in, void* d_out, int out_size, void* d_ws, size_t ws_size, hipStream_t stream) {
    static int grid = 0;
    if (grid == 0) {
        if (n_in != 15 || in_sizes[0] != M * DM || out_size != M * DM || ws_size < (PROBE ? 256 * MiB : WS_END)) { fprintf(stderr, "kernel_launch: unexpected shapes (n_in %d, in0 %d, out %d, ws %zu); nothing launched\n", n_in, n_in > 0 ? in_sizes[0] : -1, out_size, ws_size); grid = -1; return; }
        int dev = 0, cus = 0, per_cu = 0;
        if (hipGetDevice(&dev) != hipSuccess || hipDeviceGetAttribute(&cus, hipDeviceAttributeMultiprocessorCount, dev) != hipSuccess) { fprintf(stderr, "kernel_launch: device query failed\n"); grid = -1; return; }
        if (hipFuncSetAttribute((const void*)trunk_fwd, hipFuncAttributeMaxDynamicSharedMemorySize, LDS_BYTES) != hipSuccess) { fprintf(stderr, "kernel_launch: hipFuncSetAttribute failed\n"); grid = -1; return; }
        if (hipOccupancyMaxActiveBlocksPerMultiprocessor(&per_cu, (const void*)trunk_fwd, NWAVES * 64, LDS_BYTES) != hipSuccess || per_cu < 1)
            fprintf(stderr, "kernel_launch: note: occupancy query reports %d workgroups per CU\n", per_cu);
        (void)hipGetLastError();
        grid = cus;
        if (grid != 256) fprintf(stderr, "kernel_launch: %d CUs; this kernel is built for 256\n", grid);
    }
    if (grid < 0) return;
    if (hipMemsetAsync((char*)d_ws + WS_CTL, 0, CTL_ZERO_BYTES, stream) != hipSuccess) { fprintf(stderr, "kernel_launch: memset failed\n"); return; }
    Args a{};
    a.x = (const float*)d_in[0]; a.c = (const float*)d_in[1]; a.pos = (const int*)d_in[2]; a.ada_w = (const float*)d_in[3]; a.ada_b = (const float*)d_in[4]; a.norm_g = (const float*)d_in[5];
    a.a_win = (const float*)d_in[6]; a.a_qn = (const float*)d_in[7]; a.a_kn = (const float*)d_in[8]; a.a_sink = (const float*)d_in[9]; a.a_wout = (const float*)d_in[10];
    a.p_win = (const float*)d_in[11]; a.p_wg = (const float*)d_in[12]; a.p_scale = (const float*)d_in[13]; a.p_wout = (const float*)d_in[14];
    a.out = (float*)d_out; a.ws = (unsigned char*)d_ws;
#if MK_ONE_LAUNCH
    a.ph_lo = 0; a.ph_hi = N_PHASES;
    hipLaunchKernelGGL(trunk_fwd, dim3(grid), dim3(NWAVES * 64), LDS_BYTES, stream, a);
#else
    for (int ph = 0; ph < N_PHASES; ++ph) { a.ph_lo = ph; a.ph_hi = ph + 1; hipLaunchKernelGGL(trunk_fwd, dim3(grid), dim3(NWAVES * 64), LDS_BYTES, stream, a); }
#endif
}
```

```cpp
#include <hip/hip_runtime.h>
#include <hip/hip_bf16.h>
#include <cstdio>
#include <cstdint>

#ifndef MK_ONE_LAUNCH
#define MK_ONE_LAUNCH 1
#endif
#ifndef ATT_DELAY_STORE
#define ATT_DELAY_STORE 0
#endif
#ifndef PROBE
#define PROBE 0
#endif

namespace pg8 {
#define PG8_LAS __attribute__((address_space(3)))
typedef unsigned short bf16_t;
typedef short bf16x8 __attribute__((ext_vector_type(8)));
typedef float f32x4 __attribute__((ext_vector_type(4)));
typedef unsigned u32x4 __attribute__((ext_vector_type(4)));
typedef unsigned u32x2 __attribute__((ext_vector_type(2)));
constexpr int BM = 256, BK = 64, HALF = 128, HTB = HALF * BK * 2, STAGE_BYTES = 8 * HTB, NXCD = 8, WGM = 8;

__host__ __device__ __forceinline__ int lds_byte(int r, int c) { const int st = (r >> 4) * 2 + (c >> 5), rr = r & 15, cc = c & 31, ob = rr * 64 + cc * 2; return st * 1024 + (ob ^ (((ob >> 9) & 1) << 5)); }
__host__ __device__ __forceinline__ void stage_rc(int b, int& R, int& C) { const int st = b / 1024, sb = b % 1024, swz = sb ^ (((sb >> 9) & 1) << 5); R = (st >> 1) * 16 + swz / 64; C = (st & 1) * 32 + (swz % 64) / 2; }
__host__ __device__ __forceinline__ int perm32(int rho) { const int n = rho >> 4, i = rho & 15; return 8 * (i >> 2) + 4 * n + (i & 3); }

struct Unit { int pm, pn; };
struct Gemm { const bf16_t* A; const bf16_t* Bt; int M, N, K; int bsh; size_t bstr; };

struct StaticOrder {
    int nM, nN, nwg, G, c;
    __host__ __device__ void init(int M, int N, int G_, int c_) { nM = M / BM; nN = N / BM; nwg = nM * nN; G = G_; c = c_; }
    __host__ __device__ bool next(int i, Unit& u) const {
        const long L = (long)i * G + c; if (L >= nwg) return false;
        int wgid = (int)L; { const int q = nwg / NXCD, r = nwg % NXCD, xcd = wgid % NXCD, off = wgid / NXCD; wgid = (xcd < r ? xcd * (q + 1) : r * (q + 1) + (xcd - r) * q) + off; }
        const int nig = WGM * nN, gid = wgid / nig, fm = gid * WGM, gsz = (nM - fm) < WGM ? (nM - fm) : WGM;
        u.pm = fm + ((wgid % nig) % gsz); u.pn = (wgid % nig) / gsz; return true;
    }
    __device__ __forceinline__ void a_ready(const Unit&) const {}
    __device__ __forceinline__ void done(const Unit&) const {}
};

__device__ __forceinline__ unsigned cvt_pk_bf16(float lo, float hi) { unsigned r; asm volatile("v_cvt_pk_bf16_f32 %0, %1, %2" : "=v"(r) : "v"(lo), "v"(hi)); return r; }

template <class Epi, class Sched, bool ALIGN_EPI = false, bool SP2 = false>
__device__ __forceinline__ void gemm_phase(PG8_LAS unsigned char* lds, const Gemm g, const Sched& S, const Epi& E) {
    int tid_ = threadIdx.x; asm volatile("" : "+v"(tid_));
    const int tid = tid_, wid = __builtin_amdgcn_readfirstlane(tid >> 6), lane = tid & 63, wr = wid >> 2, wc = wid & 3, fr = lane & 15, fq = lane >> 4;
    const int K = g.K, nt = K / BK;
    unsigned voffA[2], voffB[2];
#pragma unroll
    for (int i = 0; i < 2; ++i) { int R, C; stage_rc(tid * 16 + i * 8192, R, C); const int Rb = Epi::PERM ? ((R & ~31) + perm32(R & 31)) : R;
        voffA[i] = (unsigned)(R * K + C) * 2u; voffB[i] = (unsigned)(Rb * K + C) * 2u; }
    const size_t kstep = (size_t)(BK * 2);
    const size_t hstep = (size_t)HALF * K * 2;
    const size_t tstep = 2 * hstep;
    const unsigned ldsw = (unsigned)wid * 1024u;
    const int aoff = lds_byte(wr * 64 + fr, fq * 8), boff = lds_byte(wc * 32 + fr, fq * 8);
#define PG8_SA(b, h) (((b) * 2 + (h)) * HTB)
#define PG8_SB(b, h) ((4 + (b) * 2 + (h)) * HTB)
#define PG8_STAGE(bufoff, gbase, voff) do { _Pragma("unroll") for (int _i = 0; _i < 2; ++_i) \
        __builtin_amdgcn_global_load_lds((const unsigned*)((const char*)(gbase) + (voff)[_i]), (PG8_LAS unsigned*)(lds + (bufoff) + ldsw + _i * 8192), 16, 0, 0); } while (0)
#define PG8_LDA(dst, b, h) do { _Pragma("unroll") for (int m = 0; m < 4; ++m) _Pragma("unroll") for (int k = 0; k < 2; ++k) dst[m][k] = *(const PG8_LAS bf16x8*)(lds + PG8_SA(b, h) + aoff + m * 2048 + k * 1024); } while (0)
#define PG8_LDB(dst, b, h) do { _Pragma("unroll") for (int n = 0; n < 2; ++n) _Pragma("unroll") for (int k = 0; k < 2; ++k) dst[n][k] = *(const PG8_LAS bf16x8*)(lds + PG8_SB(b, h) + boff + n * 2048 + k * 1024); } while (0)
#define PG8_MMA(ai, bj, At, Bt) do { __builtin_amdgcn_s_setprio(1); _Pragma("unroll") for (int m = 0; m < 4; ++m) _Pragma("unroll") for (int n = 0; n < 2; ++n) _Pragma("unroll") for (int k = 0; k < 2; ++k) \
        acc[ai][bj][m][n] = __builtin_amdgcn_mfma_f32_16x16x32_bf16(Bt[n][k], At[m][k], acc[ai][bj][m][n], 0, 0, 0); __builtin_amdgcn_s_setprio(0); } while (0)
#define PG8_WAIT_V(n) asm volatile("s_waitcnt vmcnt(" #n ")" ::: "memory")
#define PG8_WAIT_L(n) asm volatile("s_waitcnt lgkmcnt(" #n ")" ::: "memory")
#define PG8_BAR __builtin_amdgcn_s_barrier()
#define PG8_SCHED __builtin_amdgcn_sched_barrier(0)
    Unit cur, nxt; int ui = 0;
    if (!S.next(0, cur)) return;
    f32x4 acc[2][2][4][2];
    if constexpr (Epi::INIT_ACC) E.init(acc, cur, wr, wc, fr, fq);
    else {
#pragma unroll
    for (int a = 0; a < 2; ++a)
#pragma unroll
        for (int b = 0; b < 2; ++b)
#pragma unroll
            for (int m = 0; m < 4; ++m)
#pragma unroll
                for (int n = 0; n < 2; ++n) acc[a][b][m][n] = (f32x4){0.f, 0.f, 0.f, 0.f};
    }
    bf16x8 At[4][2], B0[2][2], B1[2][2];
    const char* cA = (const char*)g.A + (size_t)cur.pm * tstep; const char* cB = (const char*)g.Bt + (size_t)(cur.pm >> g.bsh) * g.bstr + (size_t)cur.pn * tstep;
    S.a_ready(cur);
    if constexpr (SP2) {
        PG8_STAGE(PG8_SB(0, 0), cB, voffB); PG8_STAGE(PG8_SB(0, 1), cB + hstep, voffB); PG8_STAGE(PG8_SA(0, 0), cA, voffA); PG8_STAGE(PG8_SA(0, 1), cA + hstep, voffA);
        if (wr == 1) PG8_BAR;
        PG8_WAIT_V(2); PG8_BAR;
        PG8_STAGE(PG8_SB(1, 0), cB + kstep, voffB); PG8_STAGE(PG8_SA(1, 0), cA + kstep, voffA); PG8_STAGE(PG8_SB(1, 1), cB + hstep + kstep, voffB);
        PG8_WAIT_V(6); PG8_BAR;
    } else {
        PG8_STAGE(PG8_SB(0, 0), cB, voffB); PG8_STAGE(PG8_SA(0, 0), cA, voffA); PG8_STAGE(PG8_SB(0, 1), cB + hstep, voffB); PG8_STAGE(PG8_SA(0, 1), cA + hstep, voffA);
        if (wr == 1) PG8_BAR;
        PG8_WAIT_V(4); PG8_BAR;
        PG8_STAGE(PG8_SB(1, 0), cB + kstep, voffB); PG8_STAGE(PG8_SA(1, 0), cA + kstep, voffA); PG8_STAGE(PG8_SB(1, 1), cB + hstep + kstep, voffB);
        PG8_WAIT_V(6); PG8_BAR;
    }
    for (;;) {
        const bool has_next = S.next(ui + 1, nxt);
        const char* nA = has_next ? (const char*)g.A + (size_t)nxt.pm * tstep : cA; const char* nB = has_next ? (const char*)g.Bt + (size_t)(nxt.pm >> g.bsh) * g.bstr + (size_t)nxt.pn * tstep : cB;
        for (int t = 0; t < nt; t += 2) {
            const bool last = (t == nt - 2);
            const char* a1 = cA + (size_t)(t + 1) * kstep;
            const char* a2 = last ? nA : cA + (size_t)(t + 2) * kstep; const char* b2 = last ? nB : cB + (size_t)(t + 2) * kstep;
            const char* a3 = a2 + kstep; const char* b3 = b2 + kstep;
            if (last && has_next) S.a_ready(nxt);
            if constexpr (SP2) {
            PG8_LDB(B0, 0, 0); PG8_LDB(B1, 0, 1); PG8_SCHED; PG8_LDA(At, 0, 0); PG8_STAGE(PG8_SA(1, 1), a1 + hstep, voffA);
            PG8_WAIT_V(8); PG8_WAIT_L(0); PG8_BAR; PG8_MMA(0, 0, At, B0); PG8_MMA(0, 1, At, B1); PG8_BAR; PG8_SCHED;
            PG8_LDA(At, 0, 1); PG8_STAGE(PG8_SB(0, 0), b2, voffB); PG8_STAGE(PG8_SB(0, 1), b2 + hstep, voffB); PG8_STAGE(PG8_SA(0, 0), a2, voffA);
            PG8_WAIT_V(8); PG8_WAIT_L(0); PG8_BAR; PG8_MMA(1, 0, At, B0); PG8_MMA(1, 1, At, B1); PG8_BAR; PG8_SCHED;
            PG8_LDB(B0, 1, 0); PG8_LDB(B1, 1, 1); PG8_SCHED; PG8_LDA(At, 1, 0); PG8_STAGE(PG8_SA(0, 1), a2 + hstep, voffA);
            PG8_WAIT_V(8); PG8_WAIT_L(0); PG8_BAR; PG8_MMA(0, 0, At, B0); PG8_MMA(0, 1, At, B1); PG8_BAR; PG8_SCHED;
            PG8_LDA(At, 1, 1); PG8_STAGE(PG8_SB(1, 0), b3, voffB); PG8_STAGE(PG8_SB(1, 1), b3 + hstep, voffB); PG8_STAGE(PG8_SA(1, 0), a3, voffA);
            PG8_WAIT_V(8); PG8_WAIT_L(0); PG8_BAR; PG8_MMA(1, 0, At, B0); PG8_MMA(1, 1, At, B1); PG8_BAR; PG8_SCHED;
            } else {
            PG8_LDB(B0, 0, 0); PG8_SCHED; PG8_LDA(At, 0, 0); PG8_STAGE(PG8_SA(1, 1), a1 + hstep, voffA);
            PG8_WAIT_L(8); PG8_BAR; PG8_WAIT_L(0); PG8_MMA(0, 0, At, B0); PG8_BAR; PG8_SCHED;
            PG8_LDB(B1, 0, 1); PG8_STAGE(PG8_SB(0, 0), b2, voffB);
            PG8_BAR; PG8_WAIT_L(0); PG8_MMA(0, 1, At, B1); PG8_BAR;
            PG8_LDA(At, 0, 1); PG8_STAGE(PG8_SA(0, 0), a2, voffA);
            PG8_BAR; PG8_WAIT_L(0); PG8_MMA(1, 0, At, B0); PG8_BAR; PG8_SCHED;
            PG8_STAGE(PG8_SB(0, 1), b2 + hstep, voffB);
            PG8_WAIT_V(6); PG8_BAR; PG8_MMA(1, 1, At, B1); PG8_BAR;
            PG8_LDB(B0, 1, 0); PG8_SCHED; PG8_LDA(At, 1, 0); PG8_STAGE(PG8_SA(0, 1), a2 + hstep, voffA);
            PG8_WAIT_L(8); PG8_BAR; PG8_WAIT_L(0); PG8_MMA(0, 0, At, B0); PG8_BAR; PG8_SCHED;
            PG8_LDB(B1, 1, 1); PG8_STAGE(PG8_SB(1, 0), b3, voffB);
            PG8_BAR; PG8_WAIT_L(0); PG8_MMA(0, 1, At, B1); PG8_BAR;
            PG8_LDA(At, 1, 1); PG8_STAGE(PG8_SA(1, 0), a3, voffA);
            PG8_BAR; PG8_WAIT_L(0); PG8_MMA(1, 0, At, B0); PG8_BAR; PG8_SCHED;
            PG8_STAGE(PG8_SB(1, 1), b3 + hstep, voffB);
            PG8_WAIT_V(6); PG8_BAR; PG8_MMA(1, 1, At, B1); PG8_BAR;
            }
        }
        if constexpr (ALIGN_EPI) { if (wr == 0) PG8_BAR; }
        if constexpr (!Epi::AFTER_DRAIN) { E(acc, cur, wr, wc, fr, fq); S.done(cur); }
        if (!has_next) break;
        if constexpr (Epi::INIT_ACC) E.init(acc, nxt, wr, wc, fr, fq);
        else {
#pragma unroll
        for (int a = 0; a < 2; ++a)
#pragma unroll
            for (int b = 0; b < 2; ++b)
#pragma unroll
                for (int m = 0; m < 4; ++m)
#pragma unroll
                    for (int n = 0; n < 2; ++n) acc[a][b][m][n] = (f32x4){0.f, 0.f, 0.f, 0.f};
        }
        cur = nxt; cA = nA; cB = nB; ++ui;
        if constexpr (ALIGN_EPI) { if (wr == 1) PG8_BAR; }
    }
    PG8_WAIT_V(0);
    if constexpr (!ALIGN_EPI) { if (wr == 0) PG8_BAR; }
    PG8_BAR;
    if constexpr (Epi::AFTER_DRAIN) { E.fused(acc, cur, wr, wc, fr, fq, lds, wid, lane); S.done(cur); }
#undef PG8_SA
#undef PG8_SB
#undef PG8_STAGE
#undef PG8_LDA
#undef PG8_LDB
#undef PG8_MMA
#undef PG8_WAIT_V
#undef PG8_WAIT_L
#undef PG8_BAR
#undef PG8_SCHED
}
}

constexpr int BATCH = 4, SEQ = 4096, DM = 1024, M = BATCH * SEQ, DEPTH = 4;
constexpr int NAIN = 2560, NPIN = 2048, MODW = 3072;
constexpr float NORM_EPS = 1e-6f, LOG2E = 1.4426950408889634f, C2 = 0.125f * 1.4426950408889634f;
constexpr int NWAVES = 8;

constexpr size_t MiB = 1u << 20, KiB = 1024;
constexpr size_t WS_CTL = 0, CTL_ZERO_BYTES = 1 * MiB;
constexpr size_t WS_MOD = 1 * MiB;
constexpr size_t WS_SBA = 1 * MiB + 256 * KiB;
constexpr size_t WS_SBP = 1 * MiB + 384 * KiB;
constexpr size_t WS_ROWSS = 1 * MiB + 512 * KiB;
constexpr size_t WS_ROPE = 2 * MiB;
constexpr size_t WS_WAIN = 4 * MiB;
constexpr size_t WS_WPIN = 14 * MiB;
constexpr size_t WS_WAOUT = 22 * MiB;
constexpr size_t WS_WPOUT = 26 * MiB;
constexpr size_t WS_CA = 30 * MiB;
constexpr size_t WS_CB = 31 * MiB;
constexpr size_t WS_XB = 36 * MiB;
constexpr size_t WS_Q = 68 * MiB;
constexpr size_t WS_SG = 100 * MiB;
constexpr size_t WS_K = 132 * MiB;
constexpr size_t WS_V = 140 * MiB;
constexpr size_t WS_WOUT = 148 * MiB;
constexpr size_t WS_END = 180 * MiB;
constexpr int CW_BAR = 4096;

constexpr int RING_BYTES = 131072;
constexpr int LDSCTL_OFF = 135168, LDS_BYTES = 139264;

#define GAS __attribute__((address_space(1)))
#define LAS __attribute__((address_space(3)))
typedef unsigned short bf16;
typedef unsigned v4u __attribute__((ext_vector_type(4)));
typedef unsigned v2u __attribute__((ext_vector_type(2)));
typedef float f32x4 __attribute__((ext_vector_type(4)));
typedef float f32x16 __attribute__((ext_vector_type(16)));
typedef short bf16x8 __attribute__((ext_vector_type(8)));
typedef short s16x4 __attribute__((ext_vector_type(4)));
typedef GAS unsigned gu32;
#define RLX_AGENT __ATOMIC_RELAXED, __HIP_MEMORY_SCOPE_AGENT
#define LDS_WAIT() asm volatile("s_waitcnt lgkmcnt(0)" ::: "memory")
#define VM_WAIT() asm volatile("s_waitcnt vmcnt(0)" ::: "memory")
__device__ __forceinline__ unsigned f2bf(float f) { unsigned u = __builtin_bit_cast(unsigned, f); return (u + 0x7fffu + ((u >> 16) & 1u)) >> 16; }
__device__ __forceinline__ unsigned pk2(float lo, float hi) { return f2bf(lo) | (f2bf(hi) << 16); }
__device__ __forceinline__ float bf_lo(unsigned w) { return __builtin_bit_cast(float, w << 16); }
__device__ __forceinline__ float bf_hi(unsigned w) { return __builtin_bit_cast(float, w & 0xffff0000u); }
__device__ __forceinline__ float silu_f(float v) { return v * __builtin_amdgcn_rcpf(1.0f + __builtin_amdgcn_exp2f(-v * LOG2E)); }

#define XB_TMO      128
#define XB_XCNT(j)  (256  + 64 * (j))
#define XB_XSUB(j)  (1280 + 64 * (j))
#define XB_XGEN(j)  (2304 + 64 * (j))
#define XB_TOP      3328
#define XB_TOPGEN   3392
#define XCD_BAR_WORDS 3456
#define XB_SPIN_CAP (1u << 18)
__device__ __forceinline__ unsigned xb_ld(unsigned* p)              { return __hip_atomic_load(p, __ATOMIC_RELAXED, __HIP_MEMORY_SCOPE_AGENT); }
__device__ __forceinline__ unsigned xb_add(unsigned* p, unsigned v) { return __hip_atomic_fetch_add(p, v, __ATOMIC_RELAXED, __HIP_MEMORY_SCOPE_AGENT); }
__device__ __forceinline__ unsigned xb_xcc_id() { return (unsigned)__builtin_amdgcn_s_getreg((3 << 11) | 20) & 0xFu; }
#define XB_SPIN(cond, bar) do { unsigned _sp = 0; while (cond) { __builtin_amdgcn_s_sleep(1); \
    if ((++_sp & 255u) == 0u) { if (xb_ld(&(bar)[XB_TMO])) break; if (_sp > XB_SPIN_CAP) { atomicAdd(&(bar)[XB_TMO], 1u); break; } } } } while (0)
struct XcdBarrier { unsigned* bar; unsigned x; volatile LAS unsigned* st; };
__device__ __forceinline__ XcdBarrier xcd_barrier_post(unsigned* bar, volatile LAS unsigned* st) {
    XcdBarrier b; b.bar = bar; b.x = xb_xcc_id(); b.st = st;
    if (threadIdx.x == 0) (void)xb_add(&bar[XB_XCNT(b.x)], 1u);
    return b;
}
__device__ __forceinline__ void xcd_barrier_complete(unsigned* bar, unsigned x, unsigned& nloc, unsigned& nx) {
    const unsigned G = gridDim.x * gridDim.y * gridDim.z;
    unsigned sum, cnt, mine, sp = 0u;
    for (;;) {
        sum = 0u; cnt = 0u; mine = 0u;
#pragma unroll
        for (unsigned j = 0; j < 16; ++j) { const unsigned c = xb_ld(&bar[XB_XCNT(j)]); sum += c; cnt += (c > 0u) ? 1u : 0u; mine = (j == x) ? c : mine; }
        if (sum == G) break;
        __builtin_amdgcn_s_sleep(1);
        if ((++sp & 255u) == 0u) { if (xb_ld(&bar[XB_TMO])) break; if (sp > XB_SPIN_CAP) { atomicAdd(&bar[XB_TMO], 1u); break; } }
    }
    nloc = mine > 0u ? mine : 1u; nx = cnt > 0u ? cnt : 1u;
}
__device__ __forceinline__ void xcd_barrier(const XcdBarrier& b) {
    asm volatile("s_waitcnt vmcnt(0)" ::: "memory");
    __syncthreads();
    if (threadIdx.x == 0) {
        unsigned* bar = b.bar;
        __builtin_amdgcn_s_waitcnt(0);
        unsigned nloc = b.st[0], nx = b.st[1];
        if (nloc == 0u) { xcd_barrier_complete(bar, b.x, nloc, nx); b.st[0] = nloc; b.st[1] = nx; }
        const unsigned old = xb_add(&bar[XB_XSUB(b.x)], 1u);
        const unsigned gen = old / nloc;
        if (old + 1u == (gen + 1u) * nloc) {
            __builtin_amdgcn_fence(__ATOMIC_RELEASE, "agent");
            asm volatile("s_waitcnt vmcnt(0)" ::: "memory");
            const unsigned og = xb_add(&bar[XB_TOP], 1u);
            const unsigned tg = og / nx;
            if (og + 1u == (tg + 1u) * nx) xb_add(&bar[XB_TOPGEN], 1u);
            else XB_SPIN(xb_ld(&bar[XB_TOPGEN]) == tg, bar);
            __builtin_amdgcn_fence(__ATOMIC_ACQUIRE, "agent");
            xb_add(&bar[XB_XGEN(b.x)], 1u);
            asm volatile("s_waitcnt vmcnt(0)" ::: "memory");
        } else {
            XB_SPIN(xb_ld(&bar[XB_XGEN(b.x)]) == gen, bar);
            __builtin_amdgcn_fence(__ATOMIC_ACQUIRE, "agent");
            asm volatile("s_waitcnt vmcnt(0)" ::: "memory");
        }
    }
    __syncthreads();
}

namespace pg8 {
__device__ __forceinline__ float row_rstd(const float* rowss, int row) {
    const float s = (rowss[row] + rowss[M + row]) + (rowss[2 * M + row] + rowss[3 * M + row]);
    return __builtin_amdgcn_rsqf(s * (1.0f / DM) + NORM_EPS);
}
__device__ __forceinline__ u32x4 pack8(const f32x4 a, const f32x4 b) { u32x4 w; w.x = cvt_pk_bf16(a[0], a[1]); w.y = cvt_pk_bf16(a[2], a[3]); w.z = cvt_pk_bf16(b[0], b[1]); w.w = cvt_pk_bf16(b[2], b[3]); return w; }

struct EpiAttnIn {
    static constexpr bool PERM = true, AFTER_DRAIN = false, INIT_ACC = false;
    const float* rowss; const float* sb; const float* qg; const float* kg; const float* rcos; const float* rsin; bf16_t *Q, *K, *V, *SG;
    __device__ __forceinline__ void operator()(const f32x4 (&acc)[2][2][4][2], const Unit& u, int wr, int wc, int fr, int fq) const {
        const int b = u.pm >> 4, pn = u.pn;
        const bool qk = pn < 5;
        int dl[2][2];
#pragma unroll
        for (int bj = 0; bj < 2; ++bj)
#pragma unroll
            for (int n = 0; n < 2; ++n) dl[bj][n] = (qk && bj == 0 && fq < 2) ? (4 * fq + 8 * n) : (32 * bj + 8 * fq + 4 * n);
        const float* sbp = sb + b * NAIN + pn * 256 + 64 * wc;
        f32x4 sbv[2][2];
#pragma unroll
        for (int bj = 0; bj < 2; ++bj)
#pragma unroll
            for (int n = 0; n < 2; ++n) sbv[bj][n] = *(const f32x4*)(sbp + dl[bj][n]);
        const int row0 = u.pm * BM + wr * 64 + fr;
        if (qk) {
            const float* gp = (pn < 4) ? qg : kg;
            f32x4 gv[2][2];
#pragma unroll
            for (int bj = 0; bj < 2; ++bj)
#pragma unroll
                for (int n = 0; n < 2; ++n) gv[bj][n] = *(const f32x4*)(gp + dl[bj][n]);
            const float osc = (pn < 4) ? C2 : 1.0f;
            bf16_t* obase = (pn < 4) ? (Q + pn * 256 + 64 * wc + 8 * fq) : (K + 64 * wc + 8 * fq);
            const int ld = (pn < 4) ? DM : 256;
#pragma unroll
            for (int ai = 0; ai < 2; ++ai)
#pragma unroll
                for (int m = 0; m < 4; ++m) {
                    const int row = row0 + ai * HALF + m * 16;
                    const float rs = row_rstd(rowss, row);
                    const f32x4 cs = *(const f32x4*)(rcos + (size_t)row * 8 + 4 * (fq & 1)), sn = *(const f32x4*)(rsin + (size_t)row * 8 + 4 * (fq & 1));
                    f32x4 v[2][2]; float ss = 0.f;
#pragma unroll
                    for (int bj = 0; bj < 2; ++bj)
#pragma unroll
                        for (int n = 0; n < 2; ++n) { v[bj][n] = acc[ai][bj][m][n] * rs + sbv[bj][n]; const f32x4 t = v[bj][n] * v[bj][n]; ss += (t[0] + t[1]) + (t[2] + t[3]); }
                    ss += __shfl_xor(ss, 16); ss += __shfl_xor(ss, 32);
                    const float rq = __builtin_amdgcn_rsqf(ss * (1.0f / 64.0f) + NORM_EPS);
#pragma unroll
                    for (int bj = 0; bj < 2; ++bj)
#pragma unroll
                        for (int n = 0; n < 2; ++n) v[bj][n] = v[bj][n] * rq * gv[bj][n];
                    if (fq < 2) { const f32x4 x1 = v[0][0], x2 = v[0][1]; v[0][0] = x1 * cs - x2 * sn; v[0][1] = x2 * cs + x1 * sn; }
#pragma unroll
                    for (int bj = 0; bj < 2; ++bj) *(u32x4*)(obase + (size_t)row * ld + 32 * bj) = pack8(v[bj][0] * osc, v[bj][1] * osc);
                    asm volatile("" ::: "memory");
                }
        } else if (pn == 5) {
            bf16_t* obase = V + 64 * wc + 8 * fq;
#pragma unroll
            for (int ai = 0; ai < 2; ++ai)
#pragma unroll
                for (int m = 0; m < 4; ++m) {
                    const int row = row0 + ai * HALF + m * 16;
                    const float rs = row_rstd(rowss, row);
#pragma unroll
                    for (int bj = 0; bj < 2; ++bj) *(u32x4*)(obase + (size_t)row * 256 + 32 * bj) = pack8(acc[ai][bj][m][0] * rs + sbv[bj][0], acc[ai][bj][m][1] * rs + sbv[bj][1]);
                    asm volatile("" ::: "memory");
                }
        } else {
            bf16_t* obase = SG + (pn - 6) * 256 + 64 * wc + 8 * fq;
#pragma unroll
            for (int ai = 0; ai < 2; ++ai)
#pragma unroll
                for (int m = 0; m < 4; ++m) {
                    const int row = row0 + ai * HALF + m * 16;
                    const float rs = row_rstd(rowss, row);
#pragma unroll
                    for (int bj = 0; bj < 2; ++bj) { f32x4 a = acc[ai][bj][m][0] * rs + sbv[bj][0], c = acc[ai][bj][m][1] * rs + sbv[bj][1];
#pragma unroll
                        for (int e = 0; e < 4; ++e) { a[e] = silu_f(a[e]); c[e] = silu_f(c[e]); }
                        *(u32x4*)(obase + (size_t)row * DM + 32 * bj) = pack8(a, c); }
                    asm volatile("" ::: "memory");
                }
        }
    }
};

struct EpiPoolIn {
    static constexpr bool PERM = true, AFTER_DRAIN = false, INIT_ACC = false;
    const float* rowss; const float* sb; bf16_t *U, *SG;
    __device__ __forceinline__ void operator()(const f32x4 (&acc)[2][2][4][2], const Unit& u, int wr, int wc, int fr, int fq) const {
        const int b = u.pm >> 4, pn = u.pn;
        const int row0 = u.pm * BM + wr * 64 + fr, colw = wc * 32 + 8 * fq;
        if (pn < 4) {
            bf16_t* obase = U + pn * 256 + colw;
#pragma unroll
            for (int ai = 0; ai < 2; ++ai)
#pragma unroll
                for (int m = 0; m < 4; ++m) {
                    const int row = row0 + ai * HALF + m * 16;
                    const float rs = row_rstd(rowss, row);
#pragma unroll
                    for (int bj = 0; bj < 2; ++bj) *(u32x4*)(obase + (size_t)row * DM + bj * HALF) = pack8(acc[ai][bj][m][0] * rs, acc[ai][bj][m][1] * rs);
                    asm volatile("" ::: "memory");
                }
        } else {
            const float* sbp = sb + b * DM + (pn - 4) * 256 + colw;
            f32x4 sbv[2][2];
#pragma unroll
            for (int bj = 0; bj < 2; ++bj)
#pragma unroll
                for (int n = 0; n < 2; ++n) sbv[bj][n] = *(const f32x4*)(sbp + bj * HALF + 4 * n);
            bf16_t* obase = SG + (pn - 4) * 256 + colw;
#pragma unroll
            for (int ai = 0; ai < 2; ++ai)
#pragma unroll
                for (int m = 0; m < 4; ++m) {
                    const int row = row0 + ai * HALF + m * 16;
                    const float rs = row_rstd(rowss, row);
#pragma unroll
                    for (int bj = 0; bj < 2; ++bj) { f32x4 a = acc[ai][bj][m][0] * rs + sbv[bj][0], c = acc[ai][bj][m][1] * rs + sbv[bj][1];
#pragma unroll
                        for (int e = 0; e < 4; ++e) { a[e] = silu_f(a[e]); c[e] = silu_f(c[e]); }
                        *(u32x4*)(obase + (size_t)row * DM + bj * HALF) = pack8(a, c); }
                    asm volatile("" ::: "memory");
                }
        }
    }
};

struct EpiComb {
    static constexpr bool PERM = true, AFTER_DRAIN = false, INIT_ACC = false;
    bf16_t* O;
    __device__ __forceinline__ void operator()(const f32x4 (&acc)[2][2][4][2], const Unit& u, int wr, int wc, int fr, int fq) const {
        const int rowt = (u.pm >> 2) * NPIN + (u.pm & 3) * 256 + wr * 64 + fr, col0 = u.pn * BM + wc * 32 + 8 * fq;
#pragma unroll
        for (int ai = 0; ai < 2; ++ai)
#pragma unroll
            for (int m = 0; m < 4; ++m) { bf16_t* rowp = O + (size_t)(rowt + ai * HALF + m * 16) * DM + col0;
#pragma unroll
                for (int bj = 0; bj < 2; ++bj) *(u32x4*)(rowp + bj * HALF) = pack8(acc[ai][bj][m][0], acc[ai][bj][m][1]); }
    }
};

struct EpiOut {
    static constexpr bool PERM = false, AFTER_DRAIN = true, INIT_ACC = true;
    const float* xin; float* xout; const float* ng_next; const float* scale_next; bf16_t* xb; float* rowss;
    __device__ __forceinline__ void init(f32x4 (&acc)[2][2][4][2], const Unit& u, int wr, int wc, int fr, int fq) const {
        const int col0 = u.pn * BM + wc * 32 + 4 * fq;
#pragma unroll
        for (int ai = 0; ai < 2; ++ai)
#pragma unroll
            for (int m = 0; m < 4; ++m) { const size_t off = (size_t)(u.pm * BM + ai * HALF + wr * 64 + m * 16 + fr) * DM + col0;
#pragma unroll
                for (int bj = 0; bj < 2; ++bj)
#pragma unroll
                    for (int n = 0; n < 2; ++n) acc[ai][bj][m][n] = *(const f32x4*)(xin + off + bj * HALF + n * 16); }
    }
    __device__ __forceinline__ void fused(f32x4 (&acc)[2][2][4][2], const Unit& u, int wr, int wc, int fr, int fq, PG8_LAS unsigned char* lds, int wid, int lane) const {
        const int b = u.pm >> 4;
        const int col0 = u.pn * BM + wc * 32 + 4 * fq;
        const bool nxt = (xb != nullptr);
        f32x4 fd[2][2];
#pragma unroll
        for (int bj = 0; bj < 2; ++bj)
#pragma unroll
            for (int n = 0; n < 2; ++n) { const int c = col0 + bj * HALF + n * 16;
                if (nxt) { const f32x4 g = *(const f32x4*)(ng_next + c), s = *(const f32x4*)(scale_next + b * MODW + c); fd[bj][n] = g * (s + 1.0f); } else fd[bj][n] = (f32x4){0.f, 0.f, 0.f, 0.f}; }
        PG8_LAS float* P = (PG8_LAS float*)lds;
#pragma unroll
        for (int ai = 0; ai < 2; ++ai)
#pragma unroll
            for (int m = 0; m < 4; ++m) {
                const int rt = ai * HALF + wr * 64 + m * 16 + fr; const size_t off = (size_t)(u.pm * BM + rt) * DM + col0;
                float ss = 0.f;
#pragma unroll
                for (int bj = 0; bj < 2; ++bj)
#pragma unroll
                    for (int n = 0; n < 2; ++n) { const f32x4 xn = acc[ai][bj][m][n];
                        *(f32x4*)(xout + off + bj * HALF + n * 16) = xn; const f32x4 t = xn * xn; ss += (t[0] + t[1]) + (t[2] + t[3]);
                        if (nxt) { const f32x4 y = xn * fd[bj][n]; u32x2 w; w.x = cvt_pk_bf16(y[0], y[1]); w.y = cvt_pk_bf16(y[2], y[3]); *(u32x2*)(xb + off + bj * HALF + n * 16) = w; } }
                ss += __shfl_xor(ss, 16); ss += __shfl_xor(ss, 32);
                if (nxt && fq == 0) P[rt * 4 + wc] = ss;
            }
        if (nxt) {
            asm volatile("s_waitcnt lgkmcnt(0)" ::: "memory"); __builtin_amdgcn_s_barrier(); asm volatile("" ::: "memory");
            const int t = wid * 64 + lane;
            if (t < 256) { const float s = (P[t * 4 + 0] + P[t * 4 + 1]) + (P[t * 4 + 2] + P[t * 4 + 3]); rowss[(size_t)u.pn * M + u.pm * BM + t] = s; }
            asm volatile("s_waitcnt lgkmcnt(0)" ::: "memory"); __builtin_amdgcn_s_barrier(); asm volatile("" ::: "memory");
        }
    }
};
}

namespace att {
typedef LAS const char* lds_cptr;
typedef LAS char* lds_ptr;
typedef short v4i16_t __attribute__((ext_vector_type(4)));
constexpr int KOFF = 0, VOFF = 49152, UBYTES = 24576, WSFOFF = 98304, OSTOFF = 100352;
__device__ __forceinline__ void glds16(const void* gsrc, unsigned lds_dst) { unsigned keep;
    asm volatile("s_mov_b32 %0, m0\n\ts_mov_b32 m0, %2\n\ts_nop 0\n\tglobal_load_lds_dwordx4 %1, off\n\ts_mov_b32 m0, %0" : "=&s"(keep) : "v"(gsrc), "s"(lds_dst) : "memory"); }
__device__ __forceinline__ s16x4 vtr(lds_cptr p) { return __builtin_bit_cast(s16x4, __builtin_amdgcn_ds_read_tr16_b64_v4i16((LAS v4i16_t*)p)); }
__device__ __forceinline__ unsigned cvtpk(float lo, float hi) { unsigned r; asm("v_cvt_pk_bf16_f32 %0, %1, %2" : "=v"(r) : "v"(lo), "v"(hi)); return r; }

__device__ __forceinline__ void dma_unit(const bf16* Kb, const bf16* Vb, int uid, int buf, unsigned lds0, int wid, int lane) {
    const int b = uid >> 8, kvh = (uid >> 6) & 3, qb = uid & 63, q0 = qb * 64; const long rowbase = (long)b * SEQ;
#pragma unroll
    for (int t = 0; t < 3; ++t) { int key = q0 - 128 + 64 * t + lane; key = key < 0 ? 0 : key;
        glds16(Kb + (rowbase + key) * 256 + kvh * 64 + wid * 8, (unsigned)__builtin_amdgcn_readfirstlane(lds0 + KOFF + buf * UBYTES + t * 8192 + wid * 1024)); }
#pragma unroll
    for (int t = 0; t < 3; ++t) { int key = q0 - 128 + 64 * t + 16 * (wid & 3) + (lane >> 2); key = key < 0 ? 0 : key;
        glds16(Vb + (rowbase + key) * 256 + kvh * 64 + (wid >> 2) * 32 + (lane & 3) * 8, (unsigned)__builtin_amdgcn_readfirstlane(lds0 + VOFF + buf * UBYTES + t * 8192 + wid * 1024)); }
}

__device__ __forceinline__ void attn_phase(LAS unsigned char* ldsb, const bf16* Qb, const bf16* Kb, const bf16* Vb, const bf16* SGb, bf16* OGb, const float* sinks, int vcu, int G) {
    int tid_ = threadIdx.x; asm volatile("" : "+v"(tid_));
    const int tid = tid_, lane = tid & 63, r32 = lane & 31, hi = lane >> 5; const int wid = __builtin_amdgcn_readfirstlane(tid >> 6);
    const int j = wid & 1, hq = wid >> 1;
    const unsigned lds0 = (unsigned)(uintptr_t)ldsb;
    LAS float* wsf = (LAS float*)(ldsb + WSFOFF) + wid * 64;
    LAS bf16* stg = (LAS bf16*)(ldsb + OSTOFF) + wid * 2048;
    const int nunits = BATCH * 4 * (SEQ / 64);
    const int per = nunits / G;
    const int uid0 = vcu * per;
    bf16x8 qn[4];
    {   const int uid = uid0; const int b = uid >> 8, kvh = (uid >> 6) & 3, qb = uid & 63; const bf16* Qw = Qb + ((long)b * SEQ + qb * 64 + 32 * j + r32) * DM + (kvh * 4 + hq) * 64;
#pragma unroll
        for (int d0 = 0; d0 < 4; ++d0) qn[d0] = *(const bf16x8*)(Qw + d0 * 16 + hi * 8);
        dma_unit(Kb, Vb, uid, 0, lds0, wid, lane); }
    v4u pend[4]; size_t pbase = 0; bool have_pend = false;
#pragma unroll
    for (int i4 = 0; i4 < 4; ++i4) pend[i4] = (v4u){0u, 0u, 0u, 0u};
    for (int i = 0; i < per; ++i) {
        const int uid = uid0 + i, buf = i & 1;
        const int b = uid >> 8, kvh = (uid >> 6) & 3, qb = uid & 63, q0 = qb * 64, h = kvh * 4 + hq; const long rowbase = (long)b * SEQ;
        bf16x8 qr[4];
        asm volatile("s_waitcnt vmcnt(0)" : "+v"(qn[0]), "+v"(qn[1]), "+v"(qn[2]), "+v"(qn[3]) :: "memory");
#pragma unroll
        for (int d0 = 0; d0 < 4; ++d0) qr[d0] = qn[d0];
        asm volatile("s_waitcnt lgkmcnt(0)\n\ts_barrier" ::: "memory");
        if (have_pend) {
#pragma unroll
            for (int i4 = 0; i4 < 4; ++i4) { const int row = i4 * 8 + (lane >> 3), ch = lane & 7; *(v4u*)(OGb + pbase + (size_t)row * DM + ch * 8) = pend[i4]; } }
        if (i + 1 < per) {
            const int u2 = uid + 1; dma_unit(Kb, Vb, u2, buf ^ 1, lds0, wid, lane);
            const int b2 = u2 >> 8, kvh2 = (u2 >> 6) & 3, qb2 = u2 & 63; const bf16* Qw = Qb + ((long)b2 * SEQ + qb2 * 64 + 32 * j + r32) * DM + (kvh2 * 4 + hq) * 64;
#pragma unroll
            for (int d0 = 0; d0 < 4; ++d0) qn[d0] = *(const bf16x8*)(Qw + d0 * 16 + hi * 8);
        }
        const size_t obase = (size_t)(rowbase + q0 + 32 * j) * DM + h * 64;
        v4u sgv[4];
#pragma unroll
        for (int i4 = 0; i4 < 4; ++i4) { const int row = i4 * 8 + (lane >> 3), ch = lane & 7; sgv[i4] = *(const v4u*)(SGb + obase + (size_t)row * DM + ch * 8); }
        const lds_cptr kp = (lds_cptr)ldsb + KOFF + buf * UBYTES + hi * 1024 + r32 * 16;
        f32x16 S[5];
#pragma unroll
        for (int ii = 0; ii < 5; ++ii) { const int kb = j + ii; const lds_cptr p = kp + (kb >> 1) * 8192 + (kb & 1) * 512;
            f32x16 a = f32x16{};
#pragma unroll
            for (int d0 = 0; d0 < 4; ++d0) { const bf16x8 kf = *(const LAS bf16x8*)(p + d0 * 2048); a = __builtin_amdgcn_mfma_f32_32x32x16_bf16(kf, qr[d0], a, 0, 0, 0); }
            S[ii] = a; }
        const float NEG = -INFINITY;
#pragma unroll
        for (int r = 0; r < 16; ++r) { const int c = (r & 3) + 8 * (r >> 2) + 4 * hi; if (!(c > r32)) S[0][r] = NEG; if (!(c <= r32)) S[4][r] = NEG; }
        if (q0 < 128) {
#pragma unroll
            for (int ii = 0; ii < 4; ++ii)
#pragma unroll
                for (int r = 0; r < 16; ++r) { const int c = (r & 3) + 8 * (r >> 2) + 4 * hi; if (q0 - 128 + 32 * (j + ii) + c < 0) S[ii][r] = NEG; }
        }
        const float sink2 = sinks[h] * LOG2E;
        float mx = sink2;
#pragma unroll
        for (int ii = 0; ii < 5; ++ii)
#pragma unroll
            for (int r = 0; r < 16; ++r) mx = __builtin_fmaxf(mx, S[ii][r]);
        { auto rr = __builtin_amdgcn_permlane32_swap(__float_as_uint(mx), __float_as_uint(mx), false, false); mx = __builtin_fmaxf(__uint_as_float(rr[0]), __uint_as_float(rr[1])); }
        float l = 0.f;
#pragma unroll
        for (int ii = 0; ii < 5; ++ii)
#pragma unroll
            for (int r = 0; r < 16; ++r) { const float p = __builtin_amdgcn_exp2f(S[ii][r] - mx); S[ii][r] = p; l += p; }
        { auto rr = __builtin_amdgcn_permlane32_swap(__float_as_uint(l), __float_as_uint(l), false, false); l = __uint_as_float(rr[0]) + __uint_as_float(rr[1]); }
        l += __builtin_amdgcn_exp2f(sink2 - mx);
        if (hi == 0) wsf[32 + r32] = __builtin_amdgcn_rcpf(l);
        f32x16 o[2]; o[0] = f32x16{}; o[1] = f32x16{};
        const lds_cptr vp = (lds_cptr)ldsb + VOFF + buf * UBYTES + ((lane >> 4) & 1) * 32 + (lane & 3) * 8 + (4 * hi + ((lane & 15) >> 2)) * 64;
#pragma unroll
        for (int ii = 0; ii < 5; ++ii) { const int kb = j + ii; const lds_cptr vt = vp + (kb >> 1) * 8192 + (kb & 1) * 2048;
#pragma unroll
            for (int s = 0; s < 2; ++s) {
                v4u pw; pw.x = cvtpk(S[ii][8 * s + 0], S[ii][8 * s + 1]); pw.y = cvtpk(S[ii][8 * s + 2], S[ii][8 * s + 3]); pw.z = cvtpk(S[ii][8 * s + 4], S[ii][8 * s + 5]); pw.w = cvtpk(S[ii][8 * s + 6], S[ii][8 * s + 7]);
                const bf16x8 pa = __builtin_bit_cast(bf16x8, pw);
#pragma unroll
                for (int d0 = 0; d0 < 2; ++d0) { const s16x4 lo = vtr(vt + d0 * 4096 + s * 1024), hh = vtr(vt + d0 * 4096 + s * 1024 + 512);
                    const bf16x8 vf = (bf16x8){lo[0], lo[1], lo[2], lo[3], hh[0], hh[1], hh[2], hh[3]};
                    o[d0] = __builtin_amdgcn_mfma_f32_32x32x16_bf16(pa, vf, o[d0], 0, 0, 0); }
            } }
        asm volatile("s_waitcnt lgkmcnt(0)" ::: "memory");
#pragma unroll
        for (int r = 0; r < 16; ++r) { const int orow = (r & 3) + 8 * (r >> 2) + 4 * hi; const float rl = wsf[32 + orow];
#pragma unroll
            for (int d0 = 0; d0 < 2; ++d0) stg[orow * 64 + d0 * 32 + r32] = (bf16)f2bf(o[d0][r] * rl); }
        asm volatile("s_waitcnt lgkmcnt(0)" ::: "memory");
#pragma unroll
        for (int i4 = 0; i4 < 4; ++i4) { const int row = i4 * 8 + (lane >> 3), ch = lane & 7;
            const v4u ov = *(const LAS v4u*)(stg + row * 64 + ch * 8); const v4u gv = sgv[i4];
            v4u w; w.x = cvtpk(bf_lo(ov.x) * bf_lo(gv.x), bf_hi(ov.x) * bf_hi(gv.x)); w.y = cvtpk(bf_lo(ov.y) * bf_lo(gv.y), bf_hi(ov.y) * bf_hi(gv.y));
            w.z = cvtpk(bf_lo(ov.z) * bf_lo(gv.z), bf_hi(ov.z) * bf_hi(gv.z)); w.w = cvtpk(bf_lo(ov.w) * bf_lo(gv.w), bf_hi(ov.w) * bf_hi(gv.w));
            pend[i4] = w; }
        pbase = obase; have_pend = true;
#if !ATT_DELAY_STORE
#pragma unroll
        for (int i4 = 0; i4 < 4; ++i4) { const int row = i4 * 8 + (lane >> 3), ch = lane & 7; *(v4u*)(OGb + pbase + (size_t)row * DM + ch * 8) = pend[i4]; }
        have_pend = false;
#endif
    }
    if (have_pend) {
#pragma unroll
        for (int i4 = 0; i4 < 4; ++i4) { const int row = i4 * 8 + (lane >> 3), ch = lane & 7; *(v4u*)(OGb + pbase + (size_t)row * DM + ch * 8) = pend[i4]; } }
    asm volatile("s_waitcnt vmcnt(0) lgkmcnt(0)\n\ts_barrier" ::: "memory");
}
}


struct Args {
    const float* x; const float* c; const int* pos; const float* ada_w; const float* ada_b; const float* norm_g;
    const float* a_win; const float* a_qn; const float* a_kn; const float* a_sink; const float* a_wout;
    const float* p_win; const float* p_wg; const float* p_scale; const float* p_wout;
    float* out; unsigned char* ws; int ph_lo, ph_hi;
};


__device__ __forceinline__ float wave_sum(float v) {
#pragma unroll
    for (int o = 1; o < 64; o <<= 1) v += __shfl_xor(v, o);
    return v;
}
__device__ __forceinline__ int attn_dst_row(int n) {
    const int tile = n >> 8, c = n & 255, wc = c >> 6, d = c & 63;
    int dp = d;
    if (tile < 5 && d < 16) dp = 8 * ((d >> 2) & 1) + 4 * (d >> 3) + (d & 3);
    return tile * 256 + 128 * (dp >> 5) + 32 * wc + (dp & 31);
}
__device__ __forceinline__ void transpose_item(const float* W, int ldw, int ncol0, int K, int nblk, bf16* WT, int row_off, int mode, LAS float* scr, int item, int lane) {
    const int kb = item / nblk, nb = item % nblk, k0 = 64 * kb, n0 = 32 * nb;
    {   const int kk8 = lane >> 3, c4 = lane & 7;
        f32x4 v[8];
#pragma unroll
        for (int i = 0; i < 8; ++i) v[i] = *(const f32x4*)(W + (size_t)(k0 + 8 * i + kk8) * ldw + ncol0 + n0 + 4 * c4);
#pragma unroll
        for (int i = 0; i < 8; ++i) { LAS float* d = scr + (8 * i + kk8) * 33 + 4 * c4; d[0] = v[i][0]; d[1] = v[i][1]; d[2] = v[i][2]; d[3] = v[i][3]; }
    }
    LDS_WAIT(); asm volatile("" ::: "memory");
    const int c = lane & 7;
#pragma unroll
    for (int jj = 0; jj < 4; ++jj) { const int n = (lane >> 3) + 8 * jj; const LAS float* s = scr + (8 * c) * 33 + n;
        v4u o; o.x = pk2(s[0 * 33], s[1 * 33]); o.y = pk2(s[2 * 33], s[3 * 33]); o.z = pk2(s[4 * 33], s[5 * 33]); o.w = pk2(s[6 * 33], s[7 * 33]);
        const int drow = mode ? attn_dst_row(n0 + n) : (n0 + n);
        *(GAS v4u*)(WT + (size_t)(row_off + drow) * K + k0 + 8 * c) = o; }
    LDS_WAIT(); asm volatile("" ::: "memory");
}


__device__ __forceinline__ void transpose_gate_item(const float* W, const float* gate  , bf16* WT  , LAS float* scr, int item, int lane) {
    const int kb = item >> 5, nb = item & 31, k0 = 64 * kb, n0 = 32 * nb;
    {   const int kk8 = lane >> 3, c4 = lane & 7;
        f32x4 v[8];
#pragma unroll
        for (int i = 0; i < 8; ++i) v[i] = *(const f32x4*)(W + (size_t)(k0 + 8 * i + kk8) * DM + n0 + 4 * c4);
#pragma unroll
        for (int i = 0; i < 8; ++i) { LAS float* d = scr + (8 * i + kk8) * 33 + 4 * c4; d[0] = v[i][0]; d[1] = v[i][1]; d[2] = v[i][2]; d[3] = v[i][3]; }
    }
    LDS_WAIT(); asm volatile("" ::: "memory");
    const int c = lane & 7;
#pragma unroll
    for (int jj = 0; jj < 4; ++jj) { const int n = (lane >> 3) + 8 * jj; const LAS float* s = scr + (8 * c) * 33 + n;
        float e[8];
#pragma unroll
        for (int q = 0; q < 8; ++q) e[q] = s[q * 33];
#pragma unroll
        for (int b = 0; b < 4; ++b) { const float g = gate[(size_t)b * MODW + n0 + n];
            v4u o; o.x = pk2(e[0] * g, e[1] * g); o.y = pk2(e[2] * g, e[3] * g); o.z = pk2(e[4] * g, e[5] * g); o.w = pk2(e[6] * g, e[7] * g);
            *(GAS v4u*)(WT + (size_t)b * DM * DM + (size_t)(n0 + n) * DM + k0 + 8 * c) = o; } }
    LDS_WAIT(); asm volatile("" ::: "memory");
}

__device__ __forceinline__ void gemv64_item(const float* W, int ldw, const LAS f32x4* vec, LAS float* red, const float* bias, float* out, int out_ld, int tid, int lane, int wave) {
    const int kk = lane >> 4, c4 = lane & 15;
    const float* wp = W + (size_t)(wave * 128 + kk) * ldw + 4 * c4;
    f32x4 ac[4]; ac[0] = ac[1] = ac[2] = ac[3] = (f32x4){0.f, 0.f, 0.f, 0.f};
#pragma unroll 16
    for (int i = 0; i < 32; ++i) { const f32x4 w = *(const f32x4*)(wp + (size_t)(4 * i) * ldw); const f32x4 s = vec[wave * 128 + 4 * i + kk];
        ac[0] += w * s.x; ac[1] += w * s.y; ac[2] += w * s.z; ac[3] += w * s.w; }
#pragma unroll
    for (int bb = 0; bb < 4; ++bb)
#pragma unroll
        for (int e = 0; e < 4; ++e) { float v = ac[bb][e]; v += __shfl_xor(v, 16); v += __shfl_xor(v, 32); ac[bb][e] = v; }
    if (kk == 0) {
#pragma unroll
        for (int bb = 0; bb < 4; ++bb) *(LAS f32x4*)(red + (wave * 4 + bb) * 64 + 4 * c4) = ac[bb]; }
    __syncthreads();
    if (tid < 256) { const int bb = tid >> 6, col = tid & 63; float s = 0.f;
#pragma unroll
        for (int w = 0; w < 8; ++w) s += red[(w * 4 + bb) * 64 + col];
        out[(size_t)bb * out_ld + col] = s + (bias ? bias[col] : 0.f); }
    __syncthreads();
}

__device__ __forceinline__ void phase_p0a(const Args& A, LAS unsigned char* lds, int vcu, int G, int tid, int lane, int wave) {
    unsigned char* ws = A.ws;
    {
        LAS f32x4* sc = (LAS f32x4*)lds;
        LAS float* red = (LAS float*)(lds + 16384);
        if (vcu < DEPTH * 48) { for (int k = tid; k < DM; k += NWAVES * 64) { f32x4 v; v.x = silu_f(A.c[k]); v.y = silu_f(A.c[DM + k]); v.z = silu_f(A.c[2 * DM + k]); v.w = silu_f(A.c[3 * DM + k]); sc[k] = v; } }
        __syncthreads();
        for (int it = vcu; it < DEPTH * 48; it += G) {
            const int l = it / 48, jb = it % 48;
            gemv64_item(A.ada_w + (size_t)l * DM * MODW + jb * 64, MODW, sc, red, A.ada_b + l * MODW + jb * 64, (float*)(ws + WS_MOD) + (size_t)l * 4 * MODW + jb * 64, MODW, tid, lane, wave);
        }
    }
    LAS float* scr = (LAS float*)(lds + 32768 + wave * 8704);
    const int gw = vcu * NWAVES + wave, NGW = G * NWAVES;
    constexpr int I_AIN = 16 * 80, I_PG = 16 * 32, I_WG = 4 * 8;
    constexpr int T0 = 2 * I_AIN, T1 = T0 + 2 * I_PG, T3 = T1, T4 = T3 + 8 * I_WG, T5 = T4 + (2 * DM) / 2, T6 = T5 + (M * 8) / 64;
    for (int it = gw; it < T6; it += NGW) {
        if (it < T0) { const int l = it / I_AIN, r = it % I_AIN; transpose_item(A.a_win + (size_t)l * DM * NAIN, NAIN, 0, DM, 80, (bf16*)(ws + WS_WAIN) + (size_t)l * NAIN * DM, 0, 1, scr, r, lane); }
        else if (it < T1) { const int q = it - T0, l = q / I_PG, r = q % I_PG; transpose_item(A.p_win + (size_t)l * DM * NPIN, NPIN, DM, DM, 32, (bf16*)(ws + WS_WPIN) + (size_t)l * NPIN * DM, DM, 0, scr, r, lane); }
        else if (it < T4) { const int q = it - T3, lg = q / I_WG, r = q % I_WG;
            transpose_item(A.p_wg + (size_t)lg * 65536, 256, 0, 256, 8, (bf16*)(ws + WS_CA) + (size_t)lg * 65536, 0, 0, scr, r, lane); }
        else if (it < T5) { const int q = 2 * (it - T4), l = q / DM, k = q % DM;
            const float* src = A.p_win + ((size_t)l * DM + k) * NPIN; bf16* dst = (bf16*)(ws + WS_CB) + (size_t)l * 4 * DM * 256 + (size_t)k * 256;
            f32x4 v[2][4];
#pragma unroll
            for (int r = 0; r < 2; ++r)
#pragma unroll
                for (int g = 0; g < 4; ++g) v[r][g] = *(const f32x4*)(src + (size_t)r * NPIN + g * 256 + 4 * lane);
#pragma unroll
            for (int r = 0; r < 2; ++r)
#pragma unroll
                for (int g = 0; g < 4; ++g) { v2u o; o.x = pk2(v[r][g][0], v[r][g][1]); o.y = pk2(v[r][g][2], v[r][g][3]); *(v2u*)(dst + (size_t)g * DM * 256 + (size_t)r * 256 + 4 * lane) = o; } }
        else { const int q = (it - T5) * 64 + lane; const int m = q >> 3, i = q & 7;
            const float invf[8] = {1.0f, 0.1939227432012558f, 0.03760603070259094f, 0.007292664609849453f, 0.0014142135623842478f, 0.00027424818836152554f, 5.318296098266728e-05f, 1.0313386155758053e-05f};
            float fr_ = invf[0];
#pragma unroll
            for (int e = 1; e < 8; ++e) fr_ = (i == e) ? invf[e] : fr_;
            const float ang = (float)A.pos[m] * fr_;
            const double a = (double)ang; const double kq = __builtin_rint(a * 0.63661977236758134308);
            double y = __builtin_fma(-kq, 1.57079632679489655800, a); y = __builtin_fma(-kq, 6.12323399573676603587e-17, y);
            const double y2 = y * y;
            double sp = -2.5052108385441718775e-08; sp = sp * y2 + 2.7557319223985890653e-06; sp = sp * y2 - 1.9841269841269841253e-04; sp = sp * y2 + 8.3333333333333332177e-03; sp = sp * y2 - 1.6666666666666665741e-01; const double sn = y + y * y2 * sp;
            double cp = 2.0876756987868098979e-09; cp = cp * y2 - 2.7557319223985888276e-07; cp = cp * y2 + 2.4801587301587301566e-05; cp = cp * y2 - 1.3888888888888889419e-03; cp = cp * y2 + 4.1666666666666664354e-02; cp = cp * y2 - 0.5; const double cs = 1.0 + y2 * cp;
            const int qd = ((int)(long long)kq) & 3;
            const double s_ = (qd == 0) ? sn : (qd == 1) ? cs : (qd == 2) ? -sn : -cs;
            const double c_ = (qd == 0) ? cs : (qd == 1) ? -sn : (qd == 2) ? -cs : sn;
            ((float*)(ws + WS_ROPE))[q] = (float)c_; ((float*)(ws + WS_ROPE))[(size_t)M * 8 + q] = (float)s_; }
    }
}

__device__ __forceinline__ void phase_p0b(const Args& A, LAS unsigned char* lds, int vcu, int G, int tid, int lane, int wave) {
    unsigned char* ws = A.ws;
    const float* mod = (const float*)(ws + WS_MOD);
    {
        pg8::Gemm g{(const bf16*)(ws + WS_CA), (const bf16*)(ws + WS_CB), 2048, DM, 256, 0, (size_t)DM * 256 * 2}; pg8::StaticOrder S; S.init(2048, DM, G, (int)blockIdx.x);
        pg8::EpiComb E{(bf16*)(ws + WS_WPIN)};
        pg8::gemm_phase<pg8::EpiComb, pg8::StaticOrder, false, true>(lds, g, S, E);
    }
    __syncthreads();
    {
        LAS f32x4* sh = (LAS f32x4*)lds; LAS float* red = (LAS float*)(lds + 16384);
        const int bxs = (int)blockIdx.x - 32;
        for (int it = bxs; it >= 0 && it < 112; it += G) {
            int mat, nb; if (it < 80) { mat = it / 40; nb = it % 40; } else { mat = 2 + (it - 80) / 16; nb = (it - 80) % 16; }
            const int layer = (mat < 2) ? 2 * mat : 2 * (mat - 2) + 1;
            const float* shp = mod + (size_t)layer * 4 * MODW;
            __syncthreads();
            for (int k = tid; k < DM; k += NWAVES * 64) { f32x4 v; v.x = shp[k]; v.y = shp[MODW + k]; v.z = shp[2 * MODW + k]; v.w = shp[3 * MODW + k]; sh[k] = v; }
            __syncthreads();
            if (mat < 2) gemv64_item(A.a_win + (size_t)mat * DM * NAIN + nb * 64, NAIN, sh, red, nullptr, (float*)(ws + WS_SBA) + (size_t)mat * 4 * NAIN + nb * 64, NAIN, tid, lane, wave);
            else gemv64_item(A.p_win + (size_t)(mat - 2) * DM * NPIN + DM + nb * 64, NPIN, sh, red, nullptr, (float*)(ws + WS_SBP) + (size_t)(mat - 2) * 4 * DM + nb * 64, DM, tid, lane, wave);
        }
        __syncthreads();
    }
    {
        LAS float* scr = (LAS float*)(lds + 32768 + wave * 8704);
        const int gw = vcu * NWAVES + wave, NGW = G * NWAVES;
        for (int it = gw; it < DEPTH * 512; it += NGW) { const int l = it >> 9, r = it & 511;
            const float* W = (l & 1) ? A.p_wout + (size_t)(l >> 1) * DM * DM : A.a_wout + (size_t)(l >> 1) * DM * DM;
            transpose_gate_item(W, mod + (size_t)l * 4 * MODW + 2 * DM, (bf16*)(ws + WS_WOUT) + (size_t)l * 4 * DM * DM, scr, r, lane); }
    }
    {
        const int gw = vcu * NWAVES + wave, NGW = G * NWAVES;
        float* rowss = (float*)(ws + WS_ROWSS); bf16* xb = (bf16*)(ws + WS_XB);
        for (int m0 = 2 * gw; m0 < M; m0 += 2 * NGW) {
            const int b = m0 >> 12; const float* scl = mod + (size_t)b * MODW + DM;
            f32x4 v[2][4];
#pragma unroll
            for (int r = 0; r < 2; ++r)
#pragma unroll
                for (int jj = 0; jj < 4; ++jj) v[r][jj] = ((const GAS f32x4*)(A.x + (size_t)(m0 + r) * DM) + lane)[64 * jj];
#pragma unroll
            for (int r = 0; r < 2; ++r) {
                GAS unsigned long long* o8 = (GAS unsigned long long*)(xb + (size_t)(m0 + r) * DM) + lane;
                float s = 0.f;
#pragma unroll
                for (int jj = 0; jj < 4; ++jj) { const f32x4 x4 = v[r][jj]; s += (x4.x * x4.x + x4.y * x4.y) + (x4.z * x4.z + x4.w * x4.w);
                    const f32x4 g = *(const f32x4*)(A.norm_g + 256 * jj + 4 * lane), sc = *(const f32x4*)(scl + 256 * jj + 4 * lane); const f32x4 y = x4 * g * (sc + 1.0f);
                    o8[64 * jj] = (unsigned long long)pk2(y.x, y.y) | ((unsigned long long)pk2(y.z, y.w) << 32); }
                s = wave_sum(s);
                if (lane == 0) { rowss[m0 + r] = s; rowss[M + m0 + r] = 0.f; rowss[2 * M + m0 + r] = 0.f; rowss[3 * M + m0 + r] = 0.f; }
            }
        }
    }
}

__device__ __forceinline__ void phase_pool(const Args& A, int lp, int vcu, int G, int lane, int wave, size_t out_off) {
    unsigned char* ws = A.ws; const bf16* U = (const bf16*)(ws + WS_Q); const bf16* SG = (const bf16*)(ws + WS_SG); bf16* OUT = (bf16*)(ws + out_off);
    const int gw = vcu * NWAVES + wave, NGW = G * NWAVES;
    for (int it = gw; it < (M / 32) * 4; it += NGW) {
        const int grp = it & 3, t0 = (it >> 2) * 32 + (lane >> 5) * 16, pos0 = t0 & (SEQ - 1), w = 2 << grp;
        const int col = grp * 256 + 8 * (lane & 31);
        const f32x4 scl0 = *(const f32x4*)(A.p_scale + (size_t)lp * DM + col), scl1 = *(const f32x4*)(A.p_scale + (size_t)lp * DM + col + 4);
        const bf16* up = U + (size_t)t0 * DM + col; const bf16* gp = SG + (size_t)t0 * DM + col; bf16* op = OUT + (size_t)t0 * DM + col;
        f32x4 S0 = (f32x4){0.f, 0.f, 0.f, 0.f}, S1 = S0;
        for (int jj = 1; jj < w; ++jj) if (pos0 - jj >= 0) { const v4u v = *(const v4u*)(up - (size_t)jj * DM); S0 += (f32x4){bf_lo(v.x), bf_hi(v.x), bf_lo(v.y), bf_hi(v.y)}; S1 += (f32x4){bf_lo(v.z), bf_hi(v.z), bf_lo(v.w), bf_hi(v.w)}; }
#pragma unroll 4
        for (int t = 0; t < 16; ++t) {
            const v4u uv = *(const v4u*)(up + (size_t)t * DM); const v4u gv = *(const v4u*)(gp + (size_t)t * DM);
            const f32x4 u0 = (f32x4){bf_lo(uv.x), bf_hi(uv.x), bf_lo(uv.y), bf_hi(uv.y)}, u1 = (f32x4){bf_lo(uv.z), bf_hi(uv.z), bf_lo(uv.w), bf_hi(uv.w)};
            S0 += u0; S1 += u1;
            const int pos = pos0 + t; const float inv = 1.0f / (float)((pos + 1 < w) ? (pos + 1) : w);
            const f32x4 o0 = (S0 * inv - u0) * scl0 * (f32x4){bf_lo(gv.x), bf_hi(gv.x), bf_lo(gv.y), bf_hi(gv.y)};
            const f32x4 o1 = (S1 * inv - u1) * scl1 * (f32x4){bf_lo(gv.z), bf_hi(gv.z), bf_lo(gv.w), bf_hi(gv.w)};
            v4u ov; ov.x = pk2(o0[0], o0[1]); ov.y = pk2(o0[2], o0[3]); ov.z = pk2(o1[0], o1[1]); ov.w = pk2(o1[2], o1[3]); *(v4u*)(op + (size_t)t * DM) = ov;
            if (pos - (w - 1) >= 0) { const v4u v = *(const v4u*)(up + ((long)t - (long)(w - 1)) * DM); S0 -= (f32x4){bf_lo(v.x), bf_hi(v.x), bf_lo(v.y), bf_hi(v.y)}; S1 -= (f32x4){bf_lo(v.z), bf_hi(v.z), bf_lo(v.w), bf_hi(v.w)}; }
        }
    }
}

constexpr int N_PHASES = 2 + 3 * DEPTH;
__global__ void __launch_bounds__(NWAVES * 64, 2) trunk_fwd(Args Aarg) {
    extern __shared__ __attribute__((aligned(16))) unsigned char lds_[];
    LAS unsigned char* lds = (LAS unsigned char*)lds_;
    volatile LAS unsigned* MISC = (volatile LAS unsigned*)(lds + LDSCTL_OFF);
    const int G = gridDim.x; const int bx = blockIdx.x; const int vcu = (G % 8 == 0) ? (bx % 8) * (G / 8) + bx / 8 : bx;
    { const int tid = threadIdx.x; for (int u = tid; u < (LDS_BYTES - LDSCTL_OFF) / 4; u += NWAVES * 64) ((LAS unsigned*)(lds + LDSCTL_OFF))[u] = 0u; }
    __syncthreads();
    const int ph_lo = Aarg.ph_lo, ph_hi = Aarg.ph_hi;
    XcdBarrier bar; bar.bar = (unsigned*)(Aarg.ws + WS_CTL) + CW_BAR; bar.x = 0; bar.st = nullptr;
    if (ph_hi - ph_lo > 1) bar = xcd_barrier_post((unsigned*)(Aarg.ws + WS_CTL) + CW_BAR, MISC + 8);

#ifndef DBG_MASK
#define DBG_MASK 0xff
#endif
#if defined(__HIP_DEVICE_COMPILE__)
#define LOAD_ARGS() const __attribute__((address_space(4))) Args* ap = (const __attribute__((address_space(4))) Args*)__builtin_amdgcn_kernarg_segment_ptr(); asm volatile("" : "+s"(ap)); const Args A = *ap; \
        int tidp = threadIdx.x; asm volatile("" : "+v"(tidp)); const int lanep = tidp & 63, wavep = __builtin_amdgcn_readfirstlane(tidp >> 6); (void)lanep; (void)wavep
#else
#define LOAD_ARGS() const Args A = Aarg; int tidp = threadIdx.x; const int lanep = tidp & 63, wavep = tidp >> 6; (void)lanep; (void)wavep
#endif
#define GRID_BAR() do { XcdBarrier b2 = bar; asm volatile("" : "+s"(b2.bar)); xcd_barrier(b2); } while (0)
#define PROLOGUE() do { \
    if (ph_lo <= 0 && 0 < ph_hi) { LOAD_ARGS(); phase_p0a(A, lds, vcu, G, tidp, lanep, wavep); if (1 < ph_hi) GRID_BAR(); } \
    if (ph_lo <= 1 && 1 < ph_hi) { LOAD_ARGS(); phase_p0b(A, lds, vcu, G, tidp, lanep, wavep); if (2 < ph_hi) GRID_BAR(); } } while (0)
    PROLOGUE();
#if PROBE == 1
    PROLOGUE();
#endif
    for (int ph = (ph_lo > 2 ? ph_lo : 2); ph < ph_hi; ++ph) {
        LOAD_ARGS();
        unsigned char* ws = A.ws;
        const float* mod = (const float*)(ws + WS_MOD);
        float* rowss = (float*)(ws + WS_ROWSS);
        bf16* XB = (bf16*)(ws + WS_XB); bf16* QB = (bf16*)(ws + WS_Q); bf16* SGB = (bf16*)(ws + WS_SG); bf16* KB = (bf16*)(ws + WS_K); bf16* VB = (bf16*)(ws + WS_V);
        {
            const int l = (ph - 2) / 3, sub = (ph - 2) % 3, jl = l >> 1; const bool is_attn = (l & 1) == 0;
            constexpr size_t DUMMY = 192 * MiB;
            if (sub == 0) {
                for (int rep = 0; rep < ((PROBE == 6 && is_attn) || (PROBE == 7 && !is_attn) ? 2 : 1); ++rep) {
                if (is_attn) {
                    pg8::Gemm g{XB, (const bf16*)(ws + WS_WAIN) + (size_t)jl * NAIN * DM, M, NAIN, DM, 30, 0}; pg8::StaticOrder S; S.init(M, NAIN, G, bx);
                    pg8::EpiAttnIn E{rowss, (const float*)(ws + WS_SBA) + (size_t)jl * 4 * NAIN, A.a_qn + jl * 64, A.a_kn + jl * 64, (const float*)(ws + WS_ROPE), (const float*)(ws + WS_ROPE) + (size_t)M * 8, QB, KB, VB, SGB};
                    pg8::gemm_phase<pg8::EpiAttnIn, pg8::StaticOrder, true, true>(lds, g, S, E);
                } else {
                    pg8::Gemm g{XB, (const bf16*)(ws + WS_WPIN) + (size_t)jl * NPIN * DM, M, NPIN, DM, 30, 0}; pg8::StaticOrder S; S.init(M, NPIN, G, bx);
                    pg8::EpiPoolIn E{rowss, (const float*)(ws + WS_SBP) + (size_t)jl * 4 * DM, QB, SGB};
                    pg8::gemm_phase<pg8::EpiPoolIn, pg8::StaticOrder, true, true>(lds, g, S, E);
                }
                if (PROBE == 6 || PROBE == 7) __syncthreads();
                }
                if (PROBE == 4) { for (int e = 0; e < 8; ++e) GRID_BAR(); }
            } else if (sub == 1) {
                if (is_attn) { if (PROBE == 2) { att::attn_phase(lds, QB, KB, VB, SGB, (bf16*)(ws + DUMMY), A.a_sink + jl * 16, vcu, G); __syncthreads(); }
                    att::attn_phase(lds, QB, KB, VB, SGB, QB, A.a_sink + jl * 16, vcu, G); }
                else { if (PROBE == 3) phase_pool(A, jl, vcu, G, lanep, wavep, DUMMY); phase_pool(A, jl, vcu, G, lanep, wavep, WS_SG); }
            } else {
                const bf16* Aop = is_attn ? QB : SGB;
                pg8::Gemm g{Aop, (const bf16*)(ws + WS_WOUT) + (size_t)l * 4 * DM * DM, M, DM, DM, 4, (size_t)DM * DM * 2}; pg8::StaticOrder S; S.init(M, DM, G, bx);
                const bool lastl = (l == DEPTH - 1);
                if (PROBE == 5) {
                    pg8::EpiOut E{l == 0 ? A.x : A.out, (float*)(ws + 192 * MiB), lastl ? nullptr : A.norm_g + (size_t)(l + 1) * DM, lastl ? nullptr : mod + (size_t)(l + 1) * 4 * MODW + DM, lastl ? nullptr : (bf16*)(ws + 192 * MiB), (float*)(ws + 191 * MiB)};
                    pg8::gemm_phase<pg8::EpiOut, pg8::StaticOrder, false, true>(lds, g, S, E); __syncthreads();
                }
                pg8::EpiOut E{l == 0 ? A.x : A.out, A.out, lastl ? nullptr : A.norm_g + (size_t)(l + 1) * DM, lastl ? nullptr : mod + (size_t)(l + 1) * 4 * MODW + DM, lastl ? nullptr : XB, rowss};
                pg8::gemm_phase<pg8::EpiOut, pg8::StaticOrder, false, true>(lds, g, S, E);
            }
        }
        if (ph + 1 < ph_hi) GRID_BAR();
    }
}

extern "C" void kernel_launch(void* const* d_in, const int* in_sizes, int n_in, void* d_out, int out_size, void* d_ws, size_t ws_size, hipStream_t stream) {
    static int grid = 0;
    if (grid == 0) {
        if (n_in != 15 || in_sizes[0] != M * DM || out_size != M * DM || ws_size < (PROBE ? 256 * MiB : WS_END)) { fprintf(stderr, "kernel_launch: unexpected shapes (n_in %d, in0 %d, out %d, ws %zu); nothing launched\n", n_in, n_in > 0 ? in_sizes[0] : -1, out_size, ws_size); grid = -1; return; }
        int dev = 0, cus = 0, per_cu = 0;
        if (hipGetDevice(&dev) != hipSuccess || hipDeviceGetAttribute(&cus, hipDeviceAttributeMultiprocessorCount, dev) != hipSuccess) { fprintf(stderr, "kernel_launch: device query failed\n"); grid = -1; return; }
        if (hipFuncSetAttribute((const void*)trunk_fwd, hipFuncAttributeMaxDynamicSharedMemorySize, LDS_BYTES) != hipSuccess) { fprintf(stderr, "kernel_launch: hipFuncSetAttribute failed\n"); grid = -1; return; }
        if (hipOccupancyMaxActiveBlocksPerMultiprocessor(&per_cu, (const void*)trunk_fwd, NWAVES * 64, LDS_BYTES) != hipSuccess || per_cu < 1)
            fprintf(stderr, "kernel_launch: note: occupancy query reports %d workgroups per CU\n", per_cu);
        (void)hipGetLastError();
        grid = cus;
        if (grid != 256) fprintf(stderr, "kernel_launch: %d CUs; this kernel is built for 256\n", grid);
    }
    if (grid < 0) return;
    if (hipMemsetAsync((char*)d_ws + WS_CTL, 0, CTL_ZERO_BYTES, stream) != hipSuccess) { fprintf(stderr, "kernel_launch: memset failed\n"); return; }
    Args a{};
    a.x = (const float*)d_in[0]; a.c = (const float*)d_in[1]; a.pos = (const int*)d_in[2]; a.ada_w = (const float*)d_in[3]; a.ada_b = (const float*)d_in[4]; a.norm_g = (const float*)d_in[5];
    a.a_win = (const float*)d_in[6]; a.a_qn = (const float*)d_in[7]; a.a_kn = (const float*)d_in[8]; a.a_sink = (const float*)d_in[9]; a.a_wout = (const float*)d_in[10];
    a.p_win = (const float*)d_in[11]; a.p_wg = (const float*)d_in[12]; a.p_scale = (const float*)d_in[13]; a.p_wout = (const float*)d_in[14];
    a.out = (float*)d_out; a.ws = (unsigned char*)d_ws;
#if MK_ONE_LAUNCH
    a.ph_lo = 0; a.ph_hi = N_PHASES;
    hipLaunchKernelGGL(trunk_fwd, dim3(grid), dim3(NWAVES * 64), LDS_BYTES, stream, a);
#else
    for (int ph = 0; ph < N_PHASES; ++ph) { a.ph_lo = ph; a.ph_hi = ph + 1; hipLaunchKernelGGL(trunk_fwd, dim3(grid), dim3(NWAVES * 64), LDS_BYTES, stream, a); }
#endif
}
```

```cpp
#include <hip/hip_runtime.h>
#include <hip/hip_bf16.h>
#include <cstdio>
#include <cstdint>

#ifndef MK_ONE_LAUNCH
#define MK_ONE_LAUNCH 1
#endif
#ifndef PROBE
#define PROBE 0
#endif

namespace pg8 {
#define PG8_LAS __attribute__((address_space(3)))
typedef unsigned short bf16_t;
typedef short bf16x8 __attribute__((ext_vector_type(8)));
typedef float f32x4 __attribute__((ext_vector_type(4)));
typedef unsigned u32x4 __attribute__((ext_vector_type(4)));
typedef unsigned u32x2 __attribute__((ext_vector_type(2)));
constexpr int BM = 256, BK = 64, HALF = 128, HTB = HALF * BK * 2, STAGE_BYTES = 8 * HTB, NXCD = 8, WGM = 8;

__host__ __device__ __forceinline__ int lds_byte(int r, int c) { const int st = (r >> 4) * 2 + (c >> 5), rr = r & 15, cc = c & 31, ob = rr * 64 + cc * 2; return st * 1024 + (ob ^ (((ob >> 9) & 1) << 5)); }
__host__ __device__ __forceinline__ void stage_rc(int b, int& R, int& C) { const int st = b / 1024, sb = b % 1024, swz = sb ^ (((sb >> 9) & 1) << 5); R = (st >> 1) * 16 + swz / 64; C = (st & 1) * 32 + (swz % 64) / 2; }
__host__ __device__ __forceinline__ int perm32(int rho) { const int n = rho >> 4, i = rho & 15; return 8 * (i >> 2) + 4 * n + (i & 3); }

struct Unit { int pm, pn; };
struct Gemm { const bf16_t* A; const bf16_t* Bt; int M, N, K; int bsh; size_t bstr; };

struct StaticOrder {
    int nM, nN, nwg, G, c;
    __host__ __device__ void init(int M, int N, int G_, int c_) { nM = M / BM; nN = N / BM; nwg = nM * nN; G = G_; c = c_; }
    __host__ __device__ bool next(int i, Unit& u) const {
        const long L = (long)i * G + c; if (L >= nwg) return false;
        int wgid = (int)L; { const int q = nwg / NXCD, r = nwg % NXCD, xcd = wgid % NXCD, off = wgid / NXCD; wgid = (xcd < r ? xcd * (q + 1) : r * (q + 1) + (xcd - r) * q) + off; }
        const int nig = WGM * nN, gid = wgid / nig, fm = gid * WGM, gsz = (nM - fm) < WGM ? (nM - fm) : WGM;
        u.pm = fm + ((wgid % nig) % gsz); u.pn = (wgid % nig) / gsz; return true;
    }
    __device__ __forceinline__ void a_ready(const Unit&) const {}
    __device__ __forceinline__ void done(const Unit&) const {}
};

__device__ __forceinline__ unsigned cvt_pk_bf16(float lo, float hi) { unsigned r; asm volatile("v_cvt_pk_bf16_f32 %0, %1, %2" : "=v"(r) : "v"(lo), "v"(hi)); return r; }

template <class Epi, class Sched, bool ALIGN_EPI = false, bool SP2 = false>
__device__ __forceinline__ void gemm_phase(PG8_LAS unsigned char* lds, const Gemm g, const Sched& S, const Epi& E) {
    int tid_ = threadIdx.x; asm volatile("" : "+v"(tid_));
    const int tid = tid_, wid = __builtin_amdgcn_readfirstlane(tid >> 6), lane = tid & 63, wr = wid >> 2, wc = wid & 3, fr = lane & 15, fq = lane >> 4;
    const int K = g.K, nt = K / BK;
    unsigned voffA[2], voffB[2];
#pragma unroll
    for (int i = 0; i < 2; ++i) { int R, C; stage_rc(tid * 16 + i * 8192, R, C); const int Rb = Epi::PERM ? ((R & ~31) + perm32(R & 31)) : R;
        voffA[i] = (unsigned)(R * K + C) * 2u; voffB[i] = (unsigned)(Rb * K + C) * 2u; }
    const size_t kstep = (size_t)(BK * 2);
    const size_t hstep = (size_t)HALF * K * 2;
    const size_t tstep = 2 * hstep;
    const unsigned ldsw = (unsigned)wid * 1024u;
    const int aoff = lds_byte(wr * 64 + fr, fq * 8), boff = lds_byte(wc * 32 + fr, fq * 8);
#define PG8_SA(b, h) (((b) * 2 + (h)) * HTB)
#define PG8_SB(b, h) ((4 + (b) * 2 + (h)) * HTB)
#define PG8_STAGE(bufoff, gbase, voff) do { _Pragma("unroll") for (int _i = 0; _i < 2; ++_i) \
        __builtin_amdgcn_global_load_lds((const unsigned*)((const char*)(gbase) + (voff)[_i]), (PG8_LAS unsigned*)(lds + (bufoff) + ldsw + _i * 8192), 16, 0, 0); } while (0)
#define PG8_LDA(dst, b, h) do { _Pragma("unroll") for (int m = 0; m < 4; ++m) _Pragma("unroll") for (int k = 0; k < 2; ++k) dst[m][k] = *(const PG8_LAS bf16x8*)(lds + PG8_SA(b, h) + aoff + m * 2048 + k * 1024); } while (0)
#define PG8_LDB(dst, b, h) do { _Pragma("unroll") for (int n = 0; n < 2; ++n) _Pragma("unroll") for (int k = 0; k < 2; ++k) dst[n][k] = *(const PG8_LAS bf16x8*)(lds + PG8_SB(b, h) + boff + n * 2048 + k * 1024); } while (0)
#define PG8_MMA(ai, bj, At, Bt) do { __builtin_amdgcn_s_setprio(1); _Pragma("unroll") for (int m = 0; m < 4; ++m) _Pragma("unroll") for (int n = 0; n < 2; ++n) _Pragma("unroll") for (int k = 0; k < 2; ++k) \
        acc[ai][bj][m][n] = __builtin_amdgcn_mfma_f32_16x16x32_bf16(Bt[n][k], At[m][k], acc[ai][bj][m][n], 0, 0, 0); __builtin_amdgcn_s_setprio(0); } while (0)
#define PG8_WAIT_V(n) asm volatile("s_waitcnt vmcnt(" #n ")" ::: "memory")
#define PG8_WAIT_L(n) asm volatile("s_waitcnt lgkmcnt(" #n ")" ::: "memory")
#define PG8_BAR __builtin_amdgcn_s_barrier()
#define PG8_SCHED __builtin_amdgcn_sched_barrier(0)
    Unit cur, nxt; int ui = 0;
    if (!S.next(0, cur)) return;
    f32x4 acc[2][2][4][2];
    if constexpr (Epi::INIT_ACC) E.init(acc, cur, wr, wc, fr, fq);
    else {
#pragma unroll
    for (int a = 0; a < 2; ++a)
#pragma unroll
        for (int b = 0; b < 2; ++b)
#pragma unroll
            for (int m = 0; m < 4; ++m)
#pragma unroll
                for (int n = 0; n < 2; ++n) acc[a][b][m][n] = (f32x4){0.f, 0.f, 0.f, 0.f};
    }
    bf16x8 At[4][2], B0[2][2], B1[2][2];
    const char* cA = (const char*)g.A + (size_t)cur.pm * tstep; const char* cB = (const char*)g.Bt + (size_t)(cur.pm >> g.bsh) * g.bstr + (size_t)cur.pn * tstep;
    S.a_ready(cur);
    if constexpr (SP2) {
        PG8_STAGE(PG8_SB(0, 0), cB, voffB); PG8_STAGE(PG8_SB(0, 1), cB + hstep, voffB); PG8_STAGE(PG8_SA(0, 0), cA, voffA); PG8_STAGE(PG8_SA(0, 1), cA + hstep, voffA);
        if (wr == 1) PG8_BAR;
        PG8_WAIT_V(2); PG8_BAR;
        PG8_STAGE(PG8_SB(1, 0), cB + kstep, voffB); PG8_STAGE(PG8_SA(1, 0), cA + kstep, voffA); PG8_STAGE(PG8_SB(1, 1), cB + hstep + kstep, voffB);
        PG8_WAIT_V(6); PG8_BAR;
    } else {
        PG8_STAGE(PG8_SB(0, 0), cB, voffB); PG8_STAGE(PG8_SA(0, 0), cA, voffA); PG8_STAGE(PG8_SB(0, 1), cB + hstep, voffB); PG8_STAGE(PG8_SA(0, 1), cA + hstep, voffA);
        if (wr == 1) PG8_BAR;
        PG8_WAIT_V(4); PG8_BAR;
        PG8_STAGE(PG8_SB(1, 0), cB + kstep, voffB); PG8_STAGE(PG8_SA(1, 0), cA + kstep, voffA); PG8_STAGE(PG8_SB(1, 1), cB + hstep + kstep, voffB);
        PG8_WAIT_V(6); PG8_BAR;
    }
    for (;;) {
        const bool has_next = S.next(ui + 1, nxt);
        const char* nA = has_next ? (const char*)g.A + (size_t)nxt.pm * tstep : cA; const char* nB = has_next ? (const char*)g.Bt + (size_t)(nxt.pm >> g.bsh) * g.bstr + (size_t)nxt.pn * tstep : cB;
        for (int t = 0; t < nt; t += 2) {
            const bool last = (t == nt - 2);
            const char* a1 = cA + (size_t)(t + 1) * kstep;
            const char* a2 = last ? nA : cA + (size_t)(t + 2) * kstep; const char* b2 = last ? nB : cB + (size_t)(t + 2) * kstep;
            const char* a3 = a2 + kstep; const char* b3 = b2 + kstep;
            if (last && has_next) S.a_ready(nxt);
            if constexpr (SP2) {
            PG8_LDB(B0, 0, 0); PG8_LDB(B1, 0, 1); PG8_SCHED; PG8_LDA(At, 0, 0); PG8_STAGE(PG8_SA(1, 1), a1 + hstep, voffA);
            PG8_WAIT_V(8); PG8_WAIT_L(0); PG8_BAR; PG8_MMA(0, 0, At, B0); PG8_MMA(0, 1, At, B1); PG8_BAR; PG8_SCHED;
            PG8_LDA(At, 0, 1); PG8_STAGE(PG8_SB(0, 0), b2, voffB); PG8_STAGE(PG8_SB(0, 1), b2 + hstep, voffB); PG8_STAGE(PG8_SA(0, 0), a2, voffA);
            PG8_WAIT_V(8); PG8_WAIT_L(0); PG8_BAR; PG8_MMA(1, 0, At, B0); PG8_MMA(1, 1, At, B1); PG8_BAR; PG8_SCHED;
            PG8_LDB(B0, 1, 0); PG8_LDB(B1, 1, 1); PG8_SCHED; PG8_LDA(At, 1, 0); PG8_STAGE(PG8_SA(0, 1), a2 + hstep, voffA);
            PG8_WAIT_V(8); PG8_WAIT_L(0); PG8_BAR; PG8_MMA(0, 0, At, B0); PG8_MMA(0, 1, At, B1); PG8_BAR; PG8_SCHED;
            PG8_LDA(At, 1, 1); PG8_STAGE(PG8_SB(1, 0), b3, voffB); PG8_STAGE(PG8_SB(1, 1), b3 + hstep, voffB); PG8_STAGE(PG8_SA(1, 0), a3, voffA);
            PG8_WAIT_V(8); PG8_WAIT_L(0); PG8_BAR; PG8_MMA(1, 0, At, B0); PG8_MMA(1, 1, At, B1); PG8_BAR; PG8_SCHED;
            } else {
            PG8_LDB(B0, 0, 0); PG8_SCHED; PG8_LDA(At, 0, 0); PG8_STAGE(PG8_SA(1, 1), a1 + hstep, voffA);
            PG8_WAIT_L(8); PG8_BAR; PG8_WAIT_L(0); PG8_MMA(0, 0, At, B0); PG8_BAR; PG8_SCHED;
            PG8_LDB(B1, 0, 1); PG8_STAGE(PG8_SB(0, 0), b2, voffB);
            PG8_BAR; PG8_WAIT_L(0); PG8_MMA(0, 1, At, B1); PG8_BAR;
            PG8_LDA(At, 0, 1); PG8_STAGE(PG8_SA(0, 0), a2, voffA);
            PG8_BAR; PG8_WAIT_L(0); PG8_MMA(1, 0, At, B0); PG8_BAR; PG8_SCHED;
            PG8_STAGE(PG8_SB(0, 1), b2 + hstep, voffB);
            PG8_WAIT_V(6); PG8_BAR; PG8_MMA(1, 1, At, B1); PG8_BAR;
            PG8_LDB(B0, 1, 0); PG8_SCHED; PG8_LDA(At, 1, 0); PG8_STAGE(PG8_SA(0, 1), a2 + hstep, voffA);
            PG8_WAIT_L(8); PG8_BAR; PG8_WAIT_L(0); PG8_MMA(0, 0, At, B0); PG8_BAR; PG8_SCHED;
            PG8_LDB(B1, 1, 1); PG8_STAGE(PG8_SB(1, 0), b3, voffB);
            PG8_BAR; PG8_WAIT_L(0); PG8_MMA(0, 1, At, B1); PG8_BAR;
            PG8_LDA(At, 1, 1); PG8_STAGE(PG8_SA(1, 0), a3, voffA);
            PG8_BAR; PG8_WAIT_L(0); PG8_MMA(1, 0, At, B0); PG8_BAR; PG8_SCHED;
            PG8_STAGE(PG8_SB(1, 1), b3 + hstep, voffB);
            PG8_WAIT_V(6); PG8_BAR; PG8_MMA(1, 1, At, B1); PG8_BAR;
            }
        }
        if constexpr (ALIGN_EPI) { if (wr == 0) PG8_BAR; }
        if constexpr (!Epi::AFTER_DRAIN) { E(acc, cur, wr, wc, fr, fq); S.done(cur); }
        if (!has_next) break;
        if constexpr (Epi::INIT_ACC) E.init(acc, nxt, wr, wc, fr, fq);
        else {
#pragma unroll
        for (int a = 0; a < 2; ++a)
#pragma unroll
            for (int b = 0; b < 2; ++b)
#pragma unroll
                for (int m = 0; m < 4; ++m)
#pragma unroll
                    for (int n = 0; n < 2; ++n) acc[a][b][m][n] = (f32x4){0.f, 0.f, 0.f, 0.f};
        }
        cur = nxt; cA = nA; cB = nB; ++ui;
        if constexpr (ALIGN_EPI) { if (wr == 1) PG8_BAR; }
    }
    PG8_WAIT_V(0);
    if constexpr (!ALIGN_EPI) { if (wr == 0) PG8_BAR; }
    PG8_BAR;
    if constexpr (Epi::AFTER_DRAIN) { E.fused(acc, cur, wr, wc, fr, fq, lds, wid, lane); S.done(cur); }
#undef PG8_SA
#undef PG8_SB
#undef PG8_STAGE
#undef PG8_LDA
#undef PG8_LDB
#undef PG8_MMA
#undef PG8_WAIT_V
#undef PG8_WAIT_L
#undef PG8_BAR
#undef PG8_SCHED
}
}

constexpr int BATCH = 4, SEQ = 4096, DM = 1024, M = BATCH * SEQ, DEPTH = 4;
constexpr int NAIN = 2560, NPIN = 2048, MODW = 3072;
constexpr float NORM_EPS = 1e-6f, LOG2E = 1.4426950408889634f, C2 = 0.125f * 1.4426950408889634f;
constexpr int NWAVES = 8;

constexpr size_t MiB = 1u << 20, KiB = 1024;
constexpr size_t WS_CTL = 0, CTL_ZERO_BYTES = 1 * MiB;
constexpr size_t WS_MOD = 1 * MiB;
constexpr size_t WS_SBA = 1 * MiB + 256 * KiB;
constexpr size_t WS_SBP = 1 * MiB + 384 * KiB;
constexpr size_t WS_ROWSS = 1 * MiB + 512 * KiB;
constexpr size_t WS_ROPE = 2 * MiB;
constexpr size_t WS_WAIN = 4 * MiB;
constexpr size_t WS_WPIN = 14 * MiB;
constexpr size_t WS_WAOUT = 22 * MiB;
constexpr size_t WS_WPOUT = 26 * MiB;
constexpr size_t WS_CA = 30 * MiB;
constexpr size_t WS_CB = 31 * MiB;
constexpr size_t WS_XB = 36 * MiB;
constexpr size_t WS_Q = 68 * MiB;
constexpr size_t WS_SG = 100 * MiB;
constexpr size_t WS_K = 132 * MiB;
constexpr size_t WS_V = 140 * MiB;
constexpr size_t WS_WOUT = 148 * MiB;
constexpr size_t WS_END = 180 * MiB;
constexpr int CW_BAR = 4096;

constexpr int RING_BYTES = 131072;
constexpr int LDSCTL_OFF = 135168, LDS_BYTES = 139264;

#define GAS __attribute__((address_space(1)))
#define LAS __attribute__((address_space(3)))
typedef unsigned short bf16;
typedef unsigned v4u __attribute__((ext_vector_type(4)));
typedef unsigned v2u __attribute__((ext_vector_type(2)));
typedef float f32x4 __attribute__((ext_vector_type(4)));
typedef float f32x16 __attribute__((ext_vector_type(16)));
typedef short bf16x8 __attribute__((ext_vector_type(8)));
typedef short s16x4 __attribute__((ext_vector_type(4)));
typedef GAS unsigned gu32;
#define RLX_AGENT __ATOMIC_RELAXED, __HIP_MEMORY_SCOPE_AGENT
#define LDS_WAIT() asm volatile("s_waitcnt lgkmcnt(0)" ::: "memory")
#define VM_WAIT() asm volatile("s_waitcnt vmcnt(0)" ::: "memory")
__device__ __forceinline__ unsigned f2bf(float f) { unsigned u = __builtin_bit_cast(unsigned, f); return (u + 0x7fffu + ((u >> 16) & 1u)) >> 16; }
__device__ __forceinline__ unsigned pk2(float lo, float hi) { return f2bf(lo) | (f2bf(hi) << 16); }
__device__ __forceinline__ float bf_lo(unsigned w) { return __builtin_bit_cast(float, w << 16); }
__device__ __forceinline__ float bf_hi(unsigned w) { return __builtin_bit_cast(float, w & 0xffff0000u); }
__device__ __forceinline__ float silu_f(float v) { return v * __builtin_amdgcn_rcpf(1.0f + __builtin_amdgcn_exp2f(-v * LOG2E)); }

#define XB_TMO      128
#define XB_XCNT(j)  (256  + 64 * (j))
#define XB_XSUB(j)  (1280 + 64 * (j))
#define XB_XGEN(j)  (2304 + 64 * (j))
#define XB_TOP      3328
#define XB_TOPGEN   3392
#define XCD_BAR_WORDS 3456
#define XB_SPIN_CAP (1u << 18)
__device__ __forceinline__ unsigned xb_ld(unsigned* p)              { return __hip_atomic_load(p, __ATOMIC_RELAXED, __HIP_MEMORY_SCOPE_AGENT); }
__device__ __forceinline__ unsigned xb_add(unsigned* p, unsigned v) { return __hip_atomic_fetch_add(p, v, __ATOMIC_RELAXED, __HIP_MEMORY_SCOPE_AGENT); }
__device__ __forceinline__ unsigned xb_xcc_id() { return (unsigned)__builtin_amdgcn_s_getreg((3 << 11) | 20) & 0xFu; }
#define XB_SPIN(cond, bar) do { unsigned _sp = 0; while (cond) { __builtin_amdgcn_s_sleep(1); \
    if ((++_sp & 255u) == 0u) { if (xb_ld(&(bar)[XB_TMO])) break; if (_sp > XB_SPIN_CAP) { atomicAdd(&(bar)[XB_TMO], 1u); break; } } } } while (0)
struct XcdBarrier { unsigned* bar; unsigned x; volatile LAS unsigned* st; };
__device__ __forceinline__ XcdBarrier xcd_barrier_post(unsigned* bar, volatile LAS unsigned* st) {
    XcdBarrier b; b.bar = bar; b.x = xb_xcc_id(); b.st = st;
    if (threadIdx.x == 0) (void)xb_add(&bar[XB_XCNT(b.x)], 1u);
    return b;
}
__device__ __forceinline__ void xcd_barrier_complete(unsigned* bar, unsigned x, unsigned& nloc, unsigned& nx) {
    const unsigned G = gridDim.x * gridDim.y * gridDim.z;
    unsigned sum, cnt, mine, sp = 0u;
    for (;;) {
        sum = 0u; cnt = 0u; mine = 0u;
#pragma unroll
        for (unsigned j = 0; j < 16; ++j) { const unsigned c = xb_ld(&bar[XB_XCNT(j)]); sum += c; cnt += (c > 0u) ? 1u : 0u; mine = (j == x) ? c : mine; }
        if (sum == G) break;
        __builtin_amdgcn_s_sleep(1);
        if ((++sp & 255u) == 0u) { if (xb_ld(&bar[XB_TMO])) break; if (sp > XB_SPIN_CAP) { atomicAdd(&bar[XB_TMO], 1u); break; } }
    }
    nloc = mine > 0u ? mine : 1u; nx = cnt > 0u ? cnt : 1u;
}
__device__ __forceinline__ void xcd_barrier(const XcdBarrier& b) {
    asm volatile("s_waitcnt vmcnt(0)" ::: "memory");
    __syncthreads();
    if (threadIdx.x == 0) {
        unsigned* bar = b.bar;
        __builtin_amdgcn_s_waitcnt(0);
        unsigned nloc = b.st[0], nx = b.st[1];
        if (nloc == 0u) { xcd_barrier_complete(bar, b.x, nloc, nx); b.st[0] = nloc; b.st[1] = nx; }
        const unsigned old = xb_add(&bar[XB_XSUB(b.x)], 1u);
        const unsigned gen = old / nloc;
        if (old + 1u == (gen + 1u) * nloc) {
            __builtin_amdgcn_fence(__ATOMIC_RELEASE, "agent");
            asm volatile("s_waitcnt vmcnt(0)" ::: "memory");
            const unsigned og = xb_add(&bar[XB_TOP], 1u);
            const unsigned tg = og / nx;
            if (og + 1u == (tg + 1u) * nx) xb_add(&bar[XB_TOPGEN], 1u);
            else XB_SPIN(xb_ld(&bar[XB_TOPGEN]) == tg, bar);
            __builtin_amdgcn_fence(__ATOMIC_ACQUIRE, "agent");
            xb_add(&bar[XB_XGEN(b.x)], 1u);
            asm volatile("s_waitcnt vmcnt(0)" ::: "memory");
        } else {
            XB_SPIN(xb_ld(&bar[XB_XGEN(b.x)]) == gen, bar);
            __builtin_amdgcn_fence(__ATOMIC_ACQUIRE, "agent");
            asm volatile("s_waitcnt vmcnt(0)" ::: "memory");
        }
    }
    __syncthreads();
}

namespace pg8 {
__device__ __forceinline__ float row_rstd(const float* rowss, int row) {
    const float s = (rowss[row] + rowss[M + row]) + (rowss[2 * M + row] + rowss[3 * M + row]);
    return __builtin_amdgcn_rsqf(s * (1.0f / DM) + NORM_EPS);
}
__device__ __forceinline__ u32x4 pack8(const f32x4 a, const f32x4 b) { u32x4 w; w.x = cvt_pk_bf16(a[0], a[1]); w.y = cvt_pk_bf16(a[2], a[3]); w.z = cvt_pk_bf16(b[0], b[1]); w.w = cvt_pk_bf16(b[2], b[3]); return w; }

struct EpiAttnIn {
    static constexpr bool PERM = true, AFTER_DRAIN = false, INIT_ACC = false;
    const float* rowss; const float* sb; const float* qg; const float* kg; const float* rcos; const float* rsin; bf16_t *Q, *K, *V, *SG;
    __device__ __forceinline__ void operator()(const f32x4 (&acc)[2][2][4][2], const Unit& u, int wr, int wc, int fr, int fq) const {
        const int b = u.pm >> 4, pn = u.pn;
        const bool qk = pn < 5;
        const int row0 = u.pm * BM + wr * 64 + fr;
        float rs[8];
#pragma unroll
        for (int h4 = 0; h4 < 2; ++h4) {
            float p[4][4];
#pragma unroll
            for (int g = 0; g < 4; ++g) { const int row = row0 + h4 * HALF + g * 16;
#pragma unroll
                for (int t = 0; t < 4; ++t) p[g][t] = rowss[(size_t)t * M + row]; }
#pragma unroll
            for (int g = 0; g < 4; ++g) rs[h4 * 4 + g] = __builtin_amdgcn_rsqf(((p[g][0] + p[g][1]) + (p[g][2] + p[g][3])) * (1.0f / DM) + NORM_EPS);
            asm volatile("" ::: "memory");
        }
        int dl[2][2];
#pragma unroll
        for (int bj = 0; bj < 2; ++bj)
#pragma unroll
            for (int n = 0; n < 2; ++n) dl[bj][n] = (qk && bj == 0 && fq < 2) ? (4 * fq + 8 * n) : (32 * bj + 8 * fq + 4 * n);
        const float* sbp = sb + b * NAIN + pn * 256 + 64 * wc;
        f32x4 sbv[2][2];
#pragma unroll
        for (int bj = 0; bj < 2; ++bj)
#pragma unroll
            for (int n = 0; n < 2; ++n) sbv[bj][n] = *(const f32x4*)(sbp + dl[bj][n]);
        if (qk) {
            const float* gp = (pn < 4) ? qg : kg;
            f32x4 gv[2][2];
#pragma unroll
            for (int bj = 0; bj < 2; ++bj)
#pragma unroll
                for (int n = 0; n < 2; ++n) gv[bj][n] = *(const f32x4*)(gp + dl[bj][n]);
            const float osc = (pn < 4) ? C2 : 1.0f;
            bf16_t* obase = (pn < 4) ? (Q + pn * 256 + 64 * wc + 8 * fq) : (K + 64 * wc + 8 * fq);
            const int ld = (pn < 4) ? DM : 256;
            const size_t ro = (size_t)row0 * 8 + 4 * (fq & 1);
            f32x4 csn = *(const f32x4*)(rcos + ro), snn = *(const f32x4*)(rsin + ro);
#pragma unroll
            for (int g = 0; g < 8; ++g) {
                const int ai = g >> 2, m = g & 3;
                const int row = row0 + ai * HALF + m * 16;
                const f32x4 cs = csn, sn = snn;
                if (g < 7) { const size_t rn = (size_t)(row0 + ((g + 1) >> 2) * HALF + ((g + 1) & 3) * 16) * 8 + 4 * (fq & 1); csn = *(const f32x4*)(rcos + rn); snn = *(const f32x4*)(rsin + rn); }
                f32x4 v[2][2]; float ss = 0.f;
#pragma unroll
                for (int bj = 0; bj < 2; ++bj)
#pragma unroll
                    for (int n = 0; n < 2; ++n) { v[bj][n] = acc[ai][bj][m][n] * rs[g] + sbv[bj][n]; const f32x4 t = v[bj][n] * v[bj][n]; ss += (t[0] + t[1]) + (t[2] + t[3]); }
                ss += __shfl_xor(ss, 16); ss += __shfl_xor(ss, 32);
                const float rq = __builtin_amdgcn_rsqf(ss * (1.0f / 64.0f) + NORM_EPS);
#pragma unroll
                for (int bj = 0; bj < 2; ++bj)
#pragma unroll
                    for (int n = 0; n < 2; ++n) v[bj][n] = v[bj][n] * rq * gv[bj][n];
                if (fq < 2) { const f32x4 x1 = v[0][0], x2 = v[0][1]; v[0][0] = x1 * cs - x2 * sn; v[0][1] = x2 * cs + x1 * sn; }
#pragma unroll
                for (int bj = 0; bj < 2; ++bj) *(u32x4*)(obase + (size_t)row * ld + 32 * bj) = pack8(v[bj][0] * osc, v[bj][1] * osc);
            }
        } else if (pn == 5) {
            bf16_t* obase = V + 64 * wc + 8 * fq;
#pragma unroll
            for (int g = 0; g < 8; ++g) { const int ai = g >> 2, m = g & 3; const int row = row0 + ai * HALF + m * 16;
#pragma unroll
                for (int bj = 0; bj < 2; ++bj) *(u32x4*)(obase + (size_t)row * 256 + 32 * bj) = pack8(acc[ai][bj][m][0] * rs[g] + sbv[bj][0], acc[ai][bj][m][1] * rs[g] + sbv[bj][1]); }
        } else {
            bf16_t* obase = SG + (pn - 6) * 256 + 64 * wc + 8 * fq;
#pragma unroll
            for (int g = 0; g < 8; ++g) { const int ai = g >> 2, m = g & 3; const int row = row0 + ai * HALF + m * 16;
#pragma unroll
                for (int bj = 0; bj < 2; ++bj) { f32x4 a = acc[ai][bj][m][0] * rs[g] + sbv[bj][0], c = acc[ai][bj][m][1] * rs[g] + sbv[bj][1];
#pragma unroll
                    for (int e = 0; e < 4; ++e) { a[e] = silu_f(a[e]); c[e] = silu_f(c[e]); }
                    *(u32x4*)(obase + (size_t)row * DM + 32 * bj) = pack8(a, c); } }
        }
    }
};

struct EpiPoolIn {
    static constexpr bool PERM = true, AFTER_DRAIN = false, INIT_ACC = false;
    const float* rowss; const float* sb; bf16_t *U, *SG;
    __device__ __forceinline__ void operator()(const f32x4 (&acc)[2][2][4][2], const Unit& u, int wr, int wc, int fr, int fq) const {
        const int b = u.pm >> 4, pn = u.pn;
        const int row0 = u.pm * BM + wr * 64 + fr, colw = wc * 32 + 8 * fq;
        float rs[8];
#pragma unroll
        for (int h4 = 0; h4 < 2; ++h4) {
            float p[4][4];
#pragma unroll
            for (int g = 0; g < 4; ++g) { const int row = row0 + h4 * HALF + g * 16;
#pragma unroll
                for (int t = 0; t < 4; ++t) p[g][t] = rowss[(size_t)t * M + row]; }
#pragma unroll
            for (int g = 0; g < 4; ++g) rs[h4 * 4 + g] = __builtin_amdgcn_rsqf(((p[g][0] + p[g][1]) + (p[g][2] + p[g][3])) * (1.0f / DM) + NORM_EPS);
            asm volatile("" ::: "memory");
        }
        if (pn < 4) {
            bf16_t* obase = U + pn * 256 + colw;
#pragma unroll
            for (int g = 0; g < 8; ++g) { const int ai = g >> 2, m = g & 3; const int row = row0 + ai * HALF + m * 16;
#pragma unroll
                for (int bj = 0; bj < 2; ++bj) *(u32x4*)(obase + (size_t)row * DM + bj * HALF) = pack8(acc[ai][bj][m][0] * rs[g], acc[ai][bj][m][1] * rs[g]); }
        } else {
            const float* sbp = sb + b * DM + (pn - 4) * 256 + colw;
            f32x4 sbv[2][2];
#pragma unroll
            for (int bj = 0; bj < 2; ++bj)
#pragma unroll
                for (int n = 0; n < 2; ++n) sbv[bj][n] = *(const f32x4*)(sbp + bj * HALF + 4 * n);
            bf16_t* obase = SG + (pn - 4) * 256 + colw;
#pragma unroll
            for (int g = 0; g < 8; ++g) { const int ai = g >> 2, m = g & 3; const int row = row0 + ai * HALF + m * 16;
#pragma unroll
                for (int bj = 0; bj < 2; ++bj) { f32x4 a = acc[ai][bj][m][0] * rs[g] + sbv[bj][0], c = acc[ai][bj][m][1] * rs[g] + sbv[bj][1];
#pragma unroll
                    for (int e = 0; e < 4; ++e) { a[e] = silu_f(a[e]); c[e] = silu_f(c[e]); }
                    *(u32x4*)(obase + (size_t)row * DM + bj * HALF) = pack8(a, c); } }
        }
    }
};

struct EpiComb {
    static constexpr bool PERM = true, AFTER_DRAIN = false, INIT_ACC = false;
    bf16_t* O;
    __device__ __forceinline__ void operator()(const f32x4 (&acc)[2][2][4][2], const Unit& u, int wr, int wc, int fr, int fq) const {
        const int rowt = (u.pm >> 2) * NPIN + (u.pm & 3) * 256 + wr * 64 + fr, col0 = u.pn * BM + wc * 32 + 8 * fq;
#pragma unroll
        for (int ai = 0; ai < 2; ++ai)
#pragma unroll
            for (int m = 0; m < 4; ++m) { bf16_t* rowp = O + (size_t)(rowt + ai * HALF + m * 16) * DM + col0;
#pragma unroll
                for (int bj = 0; bj < 2; ++bj) *(u32x4*)(rowp + bj * HALF) = pack8(acc[ai][bj][m][0], acc[ai][bj][m][1]); }
    }
};

struct EpiOut {
    static constexpr bool PERM = false, AFTER_DRAIN = true, INIT_ACC = true;
    const float* xin; float* xout; const float* ng_next; const float* scale_next; bf16_t* xb; float* rowss;
    __device__ __forceinline__ void init(f32x4 (&acc)[2][2][4][2], const Unit& u, int wr, int wc, int fr, int fq) const {
        const int col0 = u.pn * BM + wc * 32 + 4 * fq;
#pragma unroll
        for (int ai = 0; ai < 2; ++ai)
#pragma unroll
            for (int m = 0; m < 4; ++m) { const size_t off = (size_t)(u.pm * BM + ai * HALF + wr * 64 + m * 16 + fr) * DM + col0;
#pragma unroll
                for (int bj = 0; bj < 2; ++bj)
#pragma unroll
                    for (int n = 0; n < 2; ++n) acc[ai][bj][m][n] = *(const f32x4*)(xin + off + bj * HALF + n * 16); }
    }
    __device__ __forceinline__ void fused(f32x4 (&acc)[2][2][4][2], const Unit& u, int wr, int wc, int fr, int fq, PG8_LAS unsigned char* lds, int wid, int lane) const {
        const int b = u.pm >> 4;
        const int col0 = u.pn * BM + wc * 32 + 4 * fq;
        const bool nxt = (xb != nullptr);
        f32x4 fd[2][2];
#pragma unroll
        for (int bj = 0; bj < 2; ++bj)
#pragma unroll
            for (int n = 0; n < 2; ++n) { const int c = col0 + bj * HALF + n * 16;
                if (nxt) { const f32x4 g = *(const f32x4*)(ng_next + c), s = *(const f32x4*)(scale_next + b * MODW + c); fd[bj][n] = g * (s + 1.0f); } else fd[bj][n] = (f32x4){0.f, 0.f, 0.f, 0.f}; }
        PG8_LAS float* P = (PG8_LAS float*)lds;
#pragma unroll
        for (int ai = 0; ai < 2; ++ai)
#pragma unroll
            for (int m = 0; m < 4; ++m) {
                const int rt = ai * HALF + wr * 64 + m * 16 + fr; const size_t off = (size_t)(u.pm * BM + rt) * DM + col0;
                float ss = 0.f;
#pragma unroll
                for (int bj = 0; bj < 2; ++bj)
#pragma unroll
                    for (int n = 0; n < 2; ++n) { const f32x4 xn = acc[ai][bj][m][n];
                        *(f32x4*)(xout + off + bj * HALF + n * 16) = xn; const f32x4 t = xn * xn; ss += (t[0] + t[1]) + (t[2] + t[3]);
                        if (nxt) { const f32x4 y = xn * fd[bj][n]; u32x2 w; w.x = cvt_pk_bf16(y[0], y[1]); w.y = cvt_pk_bf16(y[2], y[3]); *(u32x2*)(xb + off + bj * HALF + n * 16) = w; } }
                ss += __shfl_xor(ss, 16); ss += __shfl_xor(ss, 32);
                if (nxt && fq == 0) P[rt * 4 + wc] = ss;
            }
        if (nxt) {
            asm volatile("s_waitcnt lgkmcnt(0)" ::: "memory"); __builtin_amdgcn_s_barrier(); asm volatile("" ::: "memory");
            const int t = wid * 64 + lane;
            if (t < 256) { const float s = (P[t * 4 + 0] + P[t * 4 + 1]) + (P[t * 4 + 2] + P[t * 4 + 3]); rowss[(size_t)u.pn * M + u.pm * BM + t] = s; }
            asm volatile("s_waitcnt lgkmcnt(0)" ::: "memory"); __builtin_amdgcn_s_barrier(); asm volatile("" ::: "memory");
        }
    }
};
}

namespace att {
typedef LAS const char* lds_cptr;
typedef LAS char* lds_ptr;
typedef short v4i16_t __attribute__((ext_vector_type(4)));
constexpr int KOFF = 0, VOFF = 49152, UBYTES = 24576, WSFOFF = 98304, OSTOFF = 100352;
__device__ __forceinline__ void glds16(const void* gsrc, unsigned lds_dst) { unsigned keep;
    asm volatile("s_mov_b32 %0, m0\n\ts_mov_b32 m0, %2\n\ts_nop 0\n\tglobal_load_lds_dwordx4 %1, off\n\ts_mov_b32 m0, %0" : "=&s"(keep) : "v"(gsrc), "s"(lds_dst) : "memory"); }
__device__ __forceinline__ s16x4 vtr(lds_cptr p) { return __builtin_bit_cast(s16x4, __builtin_amdgcn_ds_read_tr16_b64_v4i16((LAS v4i16_t*)p)); }
__device__ __forceinline__ unsigned cvtpk(float lo, float hi) { unsigned r; asm("v_cvt_pk_bf16_f32 %0, %1, %2" : "=v"(r) : "v"(lo), "v"(hi)); return r; }

__device__ __forceinline__ void dma_unit(const bf16* Kb, const bf16* Vb, int uid, int buf, unsigned lds0, int wid, int lane) {
    const int b = uid >> 8, kvh = (uid >> 6) & 3, qb = uid & 63, q0 = qb * 64; const long rowbase = (long)b * SEQ;
#pragma unroll
    for (int t = 0; t < 3; ++t) { int key = q0 - 128 + 64 * t + lane; key = key < 0 ? 0 : key;
        glds16(Kb + (rowbase + key) * 256 + kvh * 64 + wid * 8, (unsigned)__builtin_amdgcn_readfirstlane(lds0 + KOFF + buf * UBYTES + t * 8192 + wid * 1024)); }
#pragma unroll
    for (int t = 0; t < 3; ++t) { int key = q0 - 128 + 64 * t + 16 * (wid & 3) + (lane >> 2); key = key < 0 ? 0 : key;
        glds16(Vb + (rowbase + key) * 256 + kvh * 64 + (wid >> 2) * 32 + (lane & 3) * 8, (unsigned)__builtin_amdgcn_readfirstlane(lds0 + VOFF + buf * UBYTES + t * 8192 + wid * 1024)); }
}

__device__ __forceinline__ void attn_phase(LAS unsigned char* ldsb, const bf16* Qb, const bf16* Kb, const bf16* Vb, const bf16* SGb, bf16* OGb, const float* sinks, int vcu, int G) {
    int tid_ = threadIdx.x; asm volatile("" : "+v"(tid_));
    const int tid = tid_, lane = tid & 63, r32 = lane & 31, hi = lane >> 5; const int wid = __builtin_amdgcn_readfirstlane(tid >> 6);
    const int j = wid & 1, hq = wid >> 1;
    const unsigned lds0 = (unsigned)(uintptr_t)ldsb;
    LAS float* wsf = (LAS float*)(ldsb + WSFOFF) + wid * 64;
    LAS bf16* stg = (LAS bf16*)(ldsb + OSTOFF) + wid * 2048;
    const int nunits = BATCH * 4 * (SEQ / 64);
    const int per = nunits / G;
    const int uid0 = vcu * per;
    bf16x8 qn[4];
    {   const int uid = uid0; const int b = uid >> 8, kvh = (uid >> 6) & 3, qb = uid & 63; const bf16* Qw = Qb + ((long)b * SEQ + qb * 64 + 32 * j + r32) * DM + (kvh * 4 + hq) * 64;
#pragma unroll
        for (int d0 = 0; d0 < 4; ++d0) qn[d0] = *(const bf16x8*)(Qw + d0 * 16 + hi * 8);
        dma_unit(Kb, Vb, uid, 0, lds0, wid, lane); }
    for (int i = 0; i < per; ++i) {
        const int uid = uid0 + i, buf = i & 1;
        const int b = uid >> 8, kvh = (uid >> 6) & 3, qb = uid & 63, q0 = qb * 64, h = kvh * 4 + hq; const long rowbase = (long)b * SEQ;
        bf16x8 qr[4];
        asm volatile("s_waitcnt vmcnt(0)" : "+v"(qn[0]), "+v"(qn[1]), "+v"(qn[2]), "+v"(qn[3]) :: "memory");
#pragma unroll
        for (int d0 = 0; d0 < 4; ++d0) qr[d0] = qn[d0];
        asm volatile("s_waitcnt lgkmcnt(0)\n\ts_barrier" ::: "memory");
        if (i + 1 < per) {
            const int u2 = uid + 1; dma_unit(Kb, Vb, u2, buf ^ 1, lds0, wid, lane);
            const int b2 = u2 >> 8, kvh2 = (u2 >> 6) & 3, qb2 = u2 & 63; const bf16* Qw = Qb + ((long)b2 * SEQ + qb2 * 64 + 32 * j + r32) * DM + (kvh2 * 4 + hq) * 64;
#pragma unroll
            for (int d0 = 0; d0 < 4; ++d0) qn[d0] = *(const bf16x8*)(Qw + d0 * 16 + hi * 8);
        }
        const size_t obase = (size_t)(rowbase + q0 + 32 * j) * DM + h * 64;
        const lds_cptr kp = (lds_cptr)ldsb + KOFF + buf * UBYTES + hi * 1024 + r32 * 16;
        f32x16 S[5];
#pragma unroll
        for (int ii = 0; ii < 5; ++ii) { const int kb = j + ii; const lds_cptr p = kp + (kb >> 1) * 8192 + (kb & 1) * 512;
            f32x16 a = f32x16{};
#pragma unroll
            for (int d0 = 0; d0 < 4; ++d0) { const bf16x8 kf = *(const LAS bf16x8*)(p + d0 * 2048); a = __builtin_amdgcn_mfma_f32_32x32x16_bf16(kf, qr[d0], a, 0, 0, 0); }
            S[ii] = a; }
        const float NEG = -INFINITY;
#pragma unroll
        for (int r = 0; r < 16; ++r) { const int c = (r & 3) + 8 * (r >> 2) + 4 * hi; if (!(c > r32)) S[0][r] = NEG; if (!(c <= r32)) S[4][r] = NEG; }
        if (q0 < 128) {
#pragma unroll
            for (int ii = 0; ii < 4; ++ii)
#pragma unroll
                for (int r = 0; r < 16; ++r) { const int c = (r & 3) + 8 * (r >> 2) + 4 * hi; if (q0 - 128 + 32 * (j + ii) + c < 0) S[ii][r] = NEG; }
        }
        const float sink2 = sinks[h] * LOG2E;
        float mx = sink2;
#pragma unroll
        for (int ii = 0; ii < 5; ++ii)
#pragma unroll
            for (int r = 0; r < 16; ++r) mx = __builtin_fmaxf(mx, S[ii][r]);
        { auto rr = __builtin_amdgcn_permlane32_swap(__float_as_uint(mx), __float_as_uint(mx), false, false); mx = __builtin_fmaxf(__uint_as_float(rr[0]), __uint_as_float(rr[1])); }
        float l = 0.f;
#pragma unroll
        for (int ii = 0; ii < 5; ++ii)
#pragma unroll
            for (int r = 0; r < 16; ++r) { const float p = __builtin_amdgcn_exp2f(S[ii][r] - mx); S[ii][r] = p; l += p; }
        { auto rr = __builtin_amdgcn_permlane32_swap(__float_as_uint(l), __float_as_uint(l), false, false); l = __uint_as_float(rr[0]) + __uint_as_float(rr[1]); }
        l += __builtin_amdgcn_exp2f(sink2 - mx);
        if (hi == 0) wsf[32 + r32] = __builtin_amdgcn_rcpf(l);
        f32x16 o[2]; o[0] = f32x16{}; o[1] = f32x16{};
        const lds_cptr vp = (lds_cptr)ldsb + VOFF + buf * UBYTES + ((lane >> 4) & 1) * 32 + (lane & 3) * 8 + (4 * hi + ((lane & 15) >> 2)) * 64;
#pragma unroll
        for (int ii = 0; ii < 5; ++ii) { const int kb = j + ii; const lds_cptr vt = vp + (kb >> 1) * 8192 + (kb & 1) * 2048;
#pragma unroll
            for (int s = 0; s < 2; ++s) {
                v4u pw; pw.x = cvtpk(S[ii][8 * s + 0], S[ii][8 * s + 1]); pw.y = cvtpk(S[ii][8 * s + 2], S[ii][8 * s + 3]); pw.z = cvtpk(S[ii][8 * s + 4], S[ii][8 * s + 5]); pw.w = cvtpk(S[ii][8 * s + 6], S[ii][8 * s + 7]);
                const bf16x8 pa = __builtin_bit_cast(bf16x8, pw);
#pragma unroll
                for (int d0 = 0; d0 < 2; ++d0) { const s16x4 lo = vtr(vt + d0 * 4096 + s * 1024), hh = vtr(vt + d0 * 4096 + s * 1024 + 512);
                    const bf16x8 vf = (bf16x8){lo[0], lo[1], lo[2], lo[3], hh[0], hh[1], hh[2], hh[3]};
                    o[d0] = __builtin_amdgcn_mfma_f32_32x32x16_bf16(pa, vf, o[d0], 0, 0, 0); }
            } }
        asm volatile("s_waitcnt lgkmcnt(0)" ::: "memory");
#pragma unroll
        for (int r = 0; r < 16; ++r) { const int orow = (r & 3) + 8 * (r >> 2) + 4 * hi; const float rl = wsf[32 + orow];
#pragma unroll
            for (int d0 = 0; d0 < 2; ++d0) stg[orow * 64 + d0 * 32 + r32] = (bf16)f2bf(o[d0][r] * rl); }
        asm volatile("s_waitcnt lgkmcnt(0)" ::: "memory");
#pragma unroll
        for (int i4 = 0; i4 < 4; ++i4) { const int row = i4 * 8 + (lane >> 3), ch = lane & 7;
            const v4u ov = *(const LAS v4u*)(stg + row * 64 + ch * 8); const v4u gv = *(const v4u*)(SGb + obase + (size_t)row * DM + ch * 8);
            v4u w; w.x = cvtpk(bf_lo(ov.x) * bf_lo(gv.x), bf_hi(ov.x) * bf_hi(gv.x)); w.y = cvtpk(bf_lo(ov.y) * bf_lo(gv.y), bf_hi(ov.y) * bf_hi(gv.y));
            w.z = cvtpk(bf_lo(ov.z) * bf_lo(gv.z), bf_hi(ov.z) * bf_hi(gv.z)); w.w = cvtpk(bf_lo(ov.w) * bf_lo(gv.w), bf_hi(ov.w) * bf_hi(gv.w));
            *(v4u*)(OGb + obase + (size_t)row * DM + ch * 8) = w; }
    }
    asm volatile("s_waitcnt vmcnt(0) lgkmcnt(0)\n\ts_barrier" ::: "memory");
}
}


struct Args {
    const float* x; const float* c; const int* pos; const float* ada_w; const float* ada_b; const float* norm_g;
    const float* a_win; const float* a_qn; const float* a_kn; const float* a_sink; const float* a_wout;
    const float* p_win; const float* p_wg; const float* p_scale; const float* p_wout;
    float* out; unsigned char* ws; int ph_lo, ph_hi;
};


__device__ __forceinline__ float wave_sum(float v) {
#pragma unroll
    for (int o = 1; o < 64; o <<= 1) v += __shfl_xor(v, o);
    return v;
}
__device__ __forceinline__ int attn_dst_row(int n) {
    const int tile = n >> 8, c = n & 255, wc = c >> 6, d = c & 63;
    int dp = d;
    if (tile < 5 && d < 16) dp = 8 * ((d >> 2) & 1) + 4 * (d >> 3) + (d & 3);
    return tile * 256 + 128 * (dp >> 5) + 32 * wc + (dp & 31);
}
__device__ __forceinline__ void transpose_item(const float* W, int ldw, int ncol0, int K, int nblk, bf16* WT, int row_off, int mode, LAS float* scr, int item, int lane) {
    const int kb = item / nblk, nb = item % nblk, k0 = 64 * kb, n0 = 32 * nb;
    {   const int kk8 = lane >> 3, c4 = lane & 7;
        f32x4 v[8];
#pragma unroll
        for (int i = 0; i < 8; ++i) v[i] = *(const f32x4*)(W + (size_t)(k0 + 8 * i + kk8) * ldw + ncol0 + n0 + 4 * c4);
#pragma unroll
        for (int i = 0; i < 8; ++i) { LAS float* d = scr + (8 * i + kk8) * 33 + 4 * c4; d[0] = v[i][0]; d[1] = v[i][1]; d[2] = v[i][2]; d[3] = v[i][3]; }
    }
    LDS_WAIT(); asm volatile("" ::: "memory");
    const int c = lane & 7;
#pragma unroll
    for (int jj = 0; jj < 4; ++jj) { const int n = (lane >> 3) + 8 * jj; const LAS float* s = scr + (8 * c) * 33 + n;
        v4u o; o.x = pk2(s[0 * 33], s[1 * 33]); o.y = pk2(s[2 * 33], s[3 * 33]); o.z = pk2(s[4 * 33], s[5 * 33]); o.w = pk2(s[6 * 33], s[7 * 33]);
        const int drow = mode ? attn_dst_row(n0 + n) : (n0 + n);
        *(GAS v4u*)(WT + (size_t)(row_off + drow) * K + k0 + 8 * c) = o; }
    LDS_WAIT(); asm volatile("" ::: "memory");
}


__device__ __forceinline__ void transpose_gate_item(const float* W, const float* gate  , bf16* WT  , LAS float* scr, int item, int lane) {
    const int kb = item >> 5, nb = item & 31, k0 = 64 * kb, n0 = 32 * nb;
    {   const int kk8 = lane >> 3, c4 = lane & 7;
        f32x4 v[8];
#pragma unroll
        for (int i = 0; i < 8; ++i) v[i] = *(const f32x4*)(W + (size_t)(k0 + 8 * i + kk8) * DM + n0 + 4 * c4);
#pragma unroll
        for (int i = 0; i < 8; ++i) { LAS float* d = scr + (8 * i + kk8) * 33 + 4 * c4; d[0] = v[i][0]; d[1] = v[i][1]; d[2] = v[i][2]; d[3] = v[i][3]; }
    }
    LDS_WAIT(); asm volatile("" ::: "memory");
    const int c = lane & 7;
#pragma unroll
    for (int jj = 0; jj < 4; ++jj) { const int n = (lane >> 3) + 8 * jj; const LAS float* s = scr + (8 * c) * 33 + n;
        float e[8];
#pragma unroll
        for (int q = 0; q < 8; ++q) e[q] = s[q * 33];
#pragma unroll
        for (int b = 0; b < 4; ++b) { const float g = gate[(size_t)b * MODW + n0 + n];
            v4u o; o.x = pk2(e[0] * g, e[1] * g); o.y = pk2(e[2] * g, e[3] * g); o.z = pk2(e[4] * g, e[5] * g); o.w = pk2(e[6] * g, e[7] * g);
            *(GAS v4u*)(WT + (size_t)b * DM * DM + (size_t)(n0 + n) * DM + k0 + 8 * c) = o; } }
    LDS_WAIT(); asm volatile("" ::: "memory");
}

__device__ __forceinline__ void gemv64_item(const float* W, int ldw, const LAS f32x4* vec, LAS float* red, const float* bias, float* out, int out_ld, int tid, int lane, int wave) {
    const int kk = lane >> 4, c4 = lane & 15;
    const float* wp = W + (size_t)(wave * 128 + kk) * ldw + 4 * c4;
    f32x4 ac[4]; ac[0] = ac[1] = ac[2] = ac[3] = (f32x4){0.f, 0.f, 0.f, 0.f};
#pragma unroll 16
    for (int i = 0; i < 32; ++i) { const f32x4 w = *(const f32x4*)(wp + (size_t)(4 * i) * ldw); const f32x4 s = vec[wave * 128 + 4 * i + kk];
        ac[0] += w * s.x; ac[1] += w * s.y; ac[2] += w * s.z; ac[3] += w * s.w; }
#pragma unroll
    for (int bb = 0; bb < 4; ++bb)
#pragma unroll
        for (int e = 0; e < 4; ++e) { float v = ac[bb][e]; v += __shfl_xor(v, 16); v += __shfl_xor(v, 32); ac[bb][e] = v; }
    if (kk == 0) {
#pragma unroll
        for (int bb = 0; bb < 4; ++bb) *(LAS f32x4*)(red + (wave * 4 + bb) * 64 + 4 * c4) = ac[bb]; }
    __syncthreads();
    if (tid < 256) { const int bb = tid >> 6, col = tid & 63; float s = 0.f;
#pragma unroll
        for (int w = 0; w < 8; ++w) s += red[(w * 4 + bb) * 64 + col];
        out[(size_t)bb * out_ld + col] = s + (bias ? bias[col] : 0.f); }
    __syncthreads();
}

__device__ __forceinline__ void phase_p0a(const Args& A, LAS unsigned char* lds, int vcu, int G, int tid, int lane, int wave) {
    unsigned char* ws = A.ws;
    {
        LAS f32x4* sc = (LAS f32x4*)lds;
        LAS float* red = (LAS float*)(lds + 16384);
        if (vcu < DEPTH * 48) { for (int k = tid; k < DM; k += NWAVES * 64) { f32x4 v; v.x = silu_f(A.c[k]); v.y = silu_f(A.c[DM + k]); v.z = silu_f(A.c[2 * DM + k]); v.w = silu_f(A.c[3 * DM + k]); sc[k] = v; } }
        __syncthreads();
        for (int it = vcu; it < DEPTH * 48; it += G) {
            const int l = it / 48, jb = it % 48;
            gemv64_item(A.ada_w + (size_t)l * DM * MODW + jb * 64, MODW, sc, red, A.ada_b + l * MODW + jb * 64, (float*)(ws + WS_MOD) + (size_t)l * 4 * MODW + jb * 64, MODW, tid, lane, wave);
        }
    }
    LAS float* scr = (LAS float*)(lds + 32768 + wave * 8704);
    const int gw = vcu * NWAVES + wave, NGW = G * NWAVES;
    constexpr int I_AIN = 16 * 80, I_PG = 16 * 32, I_WG = 4 * 8;
    constexpr int T0 = 2 * I_AIN, T1 = T0 + 2 * I_PG, T3 = T1, T4 = T3 + 8 * I_WG, T5 = T4 + (2 * DM) / 2, T6 = T5 + (M * 8) / 64;
    for (int it = gw; it < T6; it += NGW) {
        if (it < T0) { const int l = it / I_AIN, r = it % I_AIN; transpose_item(A.a_win + (size_t)l * DM * NAIN, NAIN, 0, DM, 80, (bf16*)(ws + WS_WAIN) + (size_t)l * NAIN * DM, 0, 1, scr, r, lane); }
        else if (it < T1) { const int q = it - T0, l = q / I_PG, r = q % I_PG; transpose_item(A.p_win + (size_t)l * DM * NPIN, NPIN, DM, DM, 32, (bf16*)(ws + WS_WPIN) + (size_t)l * NPIN * DM, DM, 0, scr, r, lane); }
        else if (it < T4) { const int q = it - T3, lg = q / I_WG, r = q % I_WG;
            transpose_item(A.p_wg + (size_t)lg * 65536, 256, 0, 256, 8, (bf16*)(ws + WS_CA) + (size_t)lg * 65536, 0, 0, scr, r, lane); }
        else if (it < T5) { const int q = 2 * (it - T4), l = q / DM, k = q % DM;
            const float* src = A.p_win + ((size_t)l * DM + k) * NPIN; bf16* dst = (bf16*)(ws + WS_CB) + (size_t)l * 4 * DM * 256 + (size_t)k * 256;
            f32x4 v[2][4];
#pragma unroll
            for (int r = 0; r < 2; ++r)
#pragma unroll
                for (int g = 0; g < 4; ++g) v[r][g] = *(const f32x4*)(src + (size_t)r * NPIN + g * 256 + 4 * lane);
#pragma unroll
            for (int r = 0; r < 2; ++r)
#pragma unroll
                for (int g = 0; g < 4; ++g) { v2u o; o.x = pk2(v[r][g][0], v[r][g][1]); o.y = pk2(v[r][g][2], v[r][g][3]); *(v2u*)(dst + (size_t)g * DM * 256 + (size_t)r * 256 + 4 * lane) = o; } }
        else { const int q = (it - T5) * 64 + lane; const int m = q >> 3, i = q & 7;
            const float invf[8] = {1.0f, 0.1939227432012558f, 0.03760603070259094f, 0.007292664609849453f, 0.0014142135623842478f, 0.00027424818836152554f, 5.318296098266728e-05f, 1.0313386155758053e-05f};
            float fr_ = invf[0];
#pragma unroll
            for (int e = 1; e < 8; ++e) fr_ = (i == e) ? invf[e] : fr_;
            const float ang = (float)A.pos[m] * fr_;
            const double a = (double)ang; const double kq = __builtin_rint(a * 0.63661977236758134308);
            double y = __builtin_fma(-kq, 1.57079632679489655800, a); y = __builtin_fma(-kq, 6.12323399573676603587e-17, y);
            const double y2 = y * y;
            double sp = -2.5052108385441718775e-08; sp = sp * y2 + 2.7557319223985890653e-06; sp = sp * y2 - 1.9841269841269841253e-04; sp = sp * y2 + 8.3333333333333332177e-03; sp = sp * y2 - 1.6666666666666665741e-01; const double sn = y + y * y2 * sp;
            double cp = 2.0876756987868098979e-09; cp = cp * y2 - 2.7557319223985888276e-07; cp = cp * y2 + 2.4801587301587301566e-05; cp = cp * y2 - 1.3888888888888889419e-03; cp = cp * y2 + 4.1666666666666664354e-02; cp = cp * y2 - 0.5; const double cs = 1.0 + y2 * cp;
            const int qd = ((int)(long long)kq) & 3;
            const double s_ = (qd == 0) ? sn : (qd == 1) ? cs : (qd == 2) ? -sn : -cs;
            const double c_ = (qd == 0) ? cs : (qd == 1) ? -sn : (qd == 2) ? -cs : sn;
            ((float*)(ws + WS_ROPE))[q] = (float)c_; ((float*)(ws + WS_ROPE))[(size_t)M * 8 + q] = (float)s_; }
    }
}

__device__ __forceinline__ void phase_p0b(const Args& A, LAS unsigned char* lds, int vcu, int G, int tid, int lane, int wave) {
    unsigned char* ws = A.ws;
    const float* mod = (const float*)(ws + WS_MOD);
    {
        pg8::Gemm g{(const bf16*)(ws + WS_CA), (const bf16*)(ws + WS_CB), 2048, DM, 256, 0, (size_t)DM * 256 * 2}; pg8::StaticOrder S; S.init(2048, DM, G, (int)blockIdx.x);
        pg8::EpiComb E{(bf16*)(ws + WS_WPIN)};
        pg8::gemm_phase<pg8::EpiComb, pg8::StaticOrder, false, true>(lds, g, S, E);
    }
    __syncthreads();
    {
        LAS f32x4* sh = (LAS f32x4*)lds; LAS float* red = (LAS float*)(lds + 16384);
        const int bxs = (int)blockIdx.x - 32;
        for (int it = bxs; it >= 0 && it < 112; it += G) {
            int mat, nb; if (it < 80) { mat = it / 40; nb = it % 40; } else { mat = 2 + (it - 80) / 16; nb = (it - 80) % 16; }
            const int layer = (mat < 2) ? 2 * mat : 2 * (mat - 2) + 1;
            const float* shp = mod + (size_t)layer * 4 * MODW;
            __syncthreads();
            for (int k = tid; k < DM; k += NWAVES * 64) { f32x4 v; v.x = shp[k]; v.y = shp[MODW + k]; v.z = shp[2 * MODW + k]; v.w = shp[3 * MODW + k]; sh[k] = v; }
            __syncthreads();
            if (mat < 2) gemv64_item(A.a_win + (size_t)mat * DM * NAIN + nb * 64, NAIN, sh, red, nullptr, (float*)(ws + WS_SBA) + (size_t)mat * 4 * NAIN + nb * 64, NAIN, tid, lane, wave);
            else gemv64_item(A.p_win + (size_t)(mat - 2) * DM * NPIN + DM + nb * 64, NPIN, sh, red, nullptr, (float*)(ws + WS_SBP) + (size_t)(mat - 2) * 4 * DM + nb * 64, DM, tid, lane, wave);
        }
        __syncthreads();
    }
    {
        LAS float* scr = (LAS float*)(lds + 32768 + wave * 8704);
        const int gw = vcu * NWAVES + wave, NGW = G * NWAVES;
        for (int it = gw; it < DEPTH * 512; it += NGW) { const int l = it >> 9, r = it & 511;
            const float* W = (l & 1) ? A.p_wout + (size_t)(l >> 1) * DM * DM : A.a_wout + (size_t)(l >> 1) * DM * DM;
            transpose_gate_item(W, mod + (size_t)l * 4 * MODW + 2 * DM, (bf16*)(ws + WS_WOUT) + (size_t)l * 4 * DM * DM, scr, r, lane); }
    }
    {
        const int gw = vcu * NWAVES + wave, NGW = G * NWAVES;
        float* rowss = (float*)(ws + WS_ROWSS); bf16* xb = (bf16*)(ws + WS_XB);
        for (int m0 = 2 * gw; m0 < M; m0 += 2 * NGW) {
            const int b = m0 >> 12; const float* scl = mod + (size_t)b * MODW + DM;
            f32x4 v[2][4];
#pragma unroll
            for (int r = 0; r < 2; ++r)
#pragma unroll
                for (int jj = 0; jj < 4; ++jj) v[r][jj] = ((const GAS f32x4*)(A.x + (size_t)(m0 + r) * DM) + lane)[64 * jj];
#pragma unroll
            for (int r = 0; r < 2; ++r) {
                GAS unsigned long long* o8 = (GAS unsigned long long*)(xb + (size_t)(m0 + r) * DM) + lane;
                float s = 0.f;
#pragma unroll
                for (int jj = 0; jj < 4; ++jj) { const f32x4 x4 = v[r][jj]; s += (x4.x * x4.x + x4.y * x4.y) + (x4.z * x4.z + x4.w * x4.w);
                    const f32x4 g = *(const f32x4*)(A.norm_g + 256 * jj + 4 * lane), sc = *(const f32x4*)(scl + 256 * jj + 4 * lane); const f32x4 y = x4 * g * (sc + 1.0f);
                    o8[64 * jj] = (unsigned long long)pk2(y.x, y.y) | ((unsigned long long)pk2(y.z, y.w) << 32); }
                s = wave_sum(s);
                if (lane == 0) { rowss[m0 + r] = s; rowss[M + m0 + r] = 0.f; rowss[2 * M + m0 + r] = 0.f; rowss[3 * M + m0 + r] = 0.f; }
            }
        }
    }
}

__device__ __forceinline__ void phase_pool(const Args& A, int lp, int vcu, int G, int lane, int wave, size_t out_off) {
    unsigned char* ws = A.ws; const bf16* U = (const bf16*)(ws + WS_Q); const bf16* SG = (const bf16*)(ws + WS_SG); bf16* OUT = (bf16*)(ws + out_off);
    const int gw = vcu * NWAVES + wave, NGW = G * NWAVES;
    for (int it = gw; it < (M / 32) * 4; it += NGW) {
        const int grp = it & 3, t0 = (it >> 2) * 32 + (lane >> 5) * 16, pos0 = t0 & (SEQ - 1), w = 2 << grp;
        const int col = grp * 256 + 8 * (lane & 31);
        const f32x4 scl0 = *(const f32x4*)(A.p_scale + (size_t)lp * DM + col), scl1 = *(const f32x4*)(A.p_scale + (size_t)lp * DM + col + 4);
        const bf16* up = U + (size_t)t0 * DM + col; const bf16* gp = SG + (size_t)t0 * DM + col; bf16* op = OUT + (size_t)t0 * DM + col;
        f32x4 S0 = (f32x4){0.f, 0.f, 0.f, 0.f}, S1 = S0;
        for (int jj = 1; jj < w; ++jj) if (pos0 - jj >= 0) { const v4u v = *(const v4u*)(up - (size_t)jj * DM); S0 += (f32x4){bf_lo(v.x), bf_hi(v.x), bf_lo(v.y), bf_hi(v.y)}; S1 += (f32x4){bf_lo(v.z), bf_hi(v.z), bf_lo(v.w), bf_hi(v.w)}; }
#pragma unroll 4
        for (int t = 0; t < 16; ++t) {
            const v4u uv = *(const v4u*)(up + (size_t)t * DM); const v4u gv = *(const v4u*)(gp + (size_t)t * DM);
            const f32x4 u0 = (f32x4){bf_lo(uv.x), bf_hi(uv.x), bf_lo(uv.y), bf_hi(uv.y)}, u1 = (f32x4){bf_lo(uv.z), bf_hi(uv.z), bf_lo(uv.w), bf_hi(uv.w)};
            S0 += u0; S1 += u1;
            const int pos = pos0 + t; const float inv = 1.0f / (float)((pos + 1 < w) ? (pos + 1) : w);
            const f32x4 o0 = (S0 * inv - u0) * scl0 * (f32x4){bf_lo(gv.x), bf_hi(gv.x), bf_lo(gv.y), bf_hi(gv.y)};
            const f32x4 o1 = (S1 * inv - u1) * scl1 * (f32x4){bf_lo(gv.z), bf_hi(gv.z), bf_lo(gv.w), bf_hi(gv.w)};
            v4u ov; ov.x = pk2(o0[0], o0[1]); ov.y = pk2(o0[2], o0[3]); ov.z = pk2(o1[0], o1[1]); ov.w = pk2(o1[2], o1[3]); *(v4u*)(op + (size_t)t * DM) = ov;
            if (pos - (w - 1) >= 0) { const v4u v = *(const v4u*)(up + ((long)t - (long)(w - 1)) * DM); S0 -= (f32x4){bf_lo(v.x), bf_hi(v.x), bf_lo(v.y), bf_hi(v.y)}; S1 -= (f32x4){bf_lo(v.z), bf_hi(v.z), bf_lo(v.w), bf_hi(v.w)}; }
        }
    }
}

constexpr int N_PHASES = 2 + 3 * DEPTH;
__global__ void __launch_bounds__(NWAVES * 64, 2) trunk_fwd(Args Aarg) {
    extern __shared__ __attribute__((aligned(16))) unsigned char lds_[];
    LAS unsigned char* lds = (LAS unsigned char*)lds_;
    volatile LAS unsigned* MISC = (volatile LAS unsigned*)(lds + LDSCTL_OFF);
    const int G0 = gridDim.x; const int bx0 = blockIdx.x; const int vcu0 = (G0 % 8 == 0) ? (bx0 % 8) * (G0 / 8) + bx0 / 8 : bx0;
    { const int tid = threadIdx.x; for (int u = tid; u < (LDS_BYTES - LDSCTL_OFF) / 4; u += NWAVES * 64) ((LAS unsigned*)(lds + LDSCTL_OFF))[u] = 0u; }
    __syncthreads();
    const int ph_lo = Aarg.ph_lo, ph_hi = Aarg.ph_hi;
    XcdBarrier bar; bar.bar = (unsigned*)(Aarg.ws + WS_CTL) + CW_BAR; bar.x = 0; bar.st = nullptr;
    if (ph_hi - ph_lo > 1) bar = xcd_barrier_post((unsigned*)(Aarg.ws + WS_CTL) + CW_BAR, MISC + 8);

#ifndef DBG_MASK
#define DBG_MASK 0xff
#endif
#if defined(__HIP_DEVICE_COMPILE__)
#define LOAD_ARGS() const __attribute__((address_space(4))) Args* ap = (const __attribute__((address_space(4))) Args*)__builtin_amdgcn_kernarg_segment_ptr(); asm volatile("" : "+s"(ap)); const Args A = *ap; \
        int tidp = threadIdx.x; asm volatile("" : "+v"(tidp)); const int lanep = tidp & 63, wavep = __builtin_amdgcn_readfirstlane(tidp >> 6); (void)lanep; (void)wavep; \
        int vcu = vcu0, G = G0, bx = bx0; asm volatile("" : "+s"(vcu), "+s"(G), "+s"(bx))
#else
#define LOAD_ARGS() const Args A = Aarg; int tidp = threadIdx.x; const int lanep = tidp & 63, wavep = tidp >> 6; (void)lanep; (void)wavep; int vcu = vcu0, G = G0, bx = bx0
#endif
#define GRID_BAR() do { XcdBarrier b2 = bar; asm volatile("" : "+s"(b2.bar)); xcd_barrier(b2); } while (0)
#define PROLOGUE() do { \
    if (ph_lo <= 0 && 0 < ph_hi) { LOAD_ARGS(); phase_p0a(A, lds, vcu, G, tidp, lanep, wavep); if (1 < ph_hi) GRID_BAR(); } \
    if (ph_lo <= 1 && 1 < ph_hi) { LOAD_ARGS(); phase_p0b(A, lds, vcu, G, tidp, lanep, wavep); if (2 < ph_hi) GRID_BAR(); } } while (0)
    PROLOGUE();
#if PROBE == 1
    PROLOGUE();
#endif
    for (int ph = (ph_lo > 2 ? ph_lo : 2); ph < ph_hi; ++ph) {
        LOAD_ARGS();
        unsigned char* ws = A.ws;
        const float* mod = (const float*)(ws + WS_MOD);
        float* rowss = (float*)(ws + WS_ROWSS);
        bf16* XB = (bf16*)(ws + WS_XB); bf16* QB = (bf16*)(ws + WS_Q); bf16* SGB = (bf16*)(ws + WS_SG); bf16* KB = (bf16*)(ws + WS_K); bf16* VB = (bf16*)(ws + WS_V);
        {
            const int l = (ph - 2) / 3, sub = (ph - 2) % 3, jl = l >> 1; const bool is_attn = (l & 1) == 0;
            constexpr size_t DUMMY = 192 * MiB;
            if (sub == 0) {
                for (int rep = 0; rep < ((PROBE == 6 && is_attn) || (PROBE == 7 && !is_attn) ? 2 : 1); ++rep) {
                if (is_attn) {
                    pg8::Gemm g{XB, (const bf16*)(ws + WS_WAIN) + (size_t)jl * NAIN * DM, M, NAIN, DM, 30, 0}; pg8::StaticOrder S; S.init(M, NAIN, G, bx);
                    pg8::EpiAttnIn E{rowss, (const float*)(ws + WS_SBA) + (size_t)jl * 4 * NAIN, A.a_qn + jl * 64, A.a_kn + jl * 64, (const float*)(ws + WS_ROPE), (const float*)(ws + WS_ROPE) + (size_t)M * 8, QB, KB, VB, SGB};
                    pg8::gemm_phase<pg8::EpiAttnIn, pg8::StaticOrder, true, true>(lds, g, S, E);
                } else {
                    pg8::Gemm g{XB, (const bf16*)(ws + WS_WPIN) + (size_t)jl * NPIN * DM, M, NPIN, DM, 30, 0}; pg8::StaticOrder S; S.init(M, NPIN, G, bx);
                    pg8::EpiPoolIn E{rowss, (const float*)(ws + WS_SBP) + (size_t)jl * 4 * DM, QB, SGB};
                    pg8::gemm_phase<pg8::EpiPoolIn, pg8::StaticOrder, true, true>(lds, g, S, E);
                }
                if (PROBE == 6 || PROBE == 7) __syncthreads();
                }
                if (PROBE == 4) { for (int e = 0; e < 8; ++e) GRID_BAR(); }
            } else if (sub == 1) {
                if (is_attn) { if (PROBE == 2) { att::attn_phase(lds, QB, KB, VB, SGB, (bf16*)(ws + DUMMY), A.a_sink + jl * 16, vcu, G); __syncthreads(); }
                    att::attn_phase(lds, QB, KB, VB, SGB, QB, A.a_sink + jl * 16, vcu, G); }
                else { if (PROBE == 3) phase_pool(A, jl, vcu, G, lanep, wavep, DUMMY); phase_pool(A, jl, vcu, G, lanep, wavep, WS_SG); }
            } else {
                const bf16* Aop = is_attn ? QB : SGB;
                pg8::Gemm g{Aop, (const bf16*)(ws + WS_WOUT) + (size_t)l * 4 * DM * DM, M, DM, DM, 4, (size_t)DM * DM * 2}; pg8::StaticOrder S; S.init(M, DM, G, bx);
                const bool lastl = (l == DEPTH - 1);
                if (PROBE == 5) {
                    pg8::EpiOut E{l == 0 ? A.x : A.out, (float*)(ws + 192 * MiB), lastl ? nullptr : A.norm_g + (size_t)(l + 1) * DM, lastl ? nullptr : mod + (size_t)(l + 1) * 4 * MODW + DM, lastl ? nullptr : (bf16*)(ws + 192 * MiB), (float*)(ws + 191 * MiB)};
                    pg8::gemm_phase<pg8::EpiOut, pg8::StaticOrder, false, true>(lds, g, S, E); __syncthreads();
                }
                pg8::EpiOut E{l == 0 ? A.x : A.out, A.out, lastl ? nullptr : A.norm_g + (size_t)(l + 1) * DM, lastl ? nullptr : mod + (size_t)(l + 1) * 4 * MODW + DM, lastl ? nullptr : XB, rowss};
                pg8::gemm_phase<pg8::EpiOut, pg8::StaticOrder, false, true>(lds, g, S, E);
            }
        }
        if (ph + 1 < ph_hi) GRID_BAR();
    }
}

extern "C" void kernel_launch(void* const* d_in, const int* in_sizes, int n_in, void* d_out, int out_size, void* d_ws, size_t ws_size, hipStream_t stream) {
    static int grid = 0;
    if (grid == 0) {
        if (n_in != 15 || in_sizes[0] != M * DM || out_size != M * DM || ws_size < (PROBE ? 256 * MiB : WS_END)) { fprintf(stderr, "kernel_launch: unexpected shapes (n_in %d, in0 %d, out %d, ws %zu); nothing launched\n", n_in, n_in > 0 ? in_sizes[0] : -1, out_size, ws_size); grid = -1; return; }
        int dev = 0, cus = 0, per_cu = 0;
        if (hipGetDevice(&dev) != hipSuccess || hipDeviceGetAttribute(&cus, hipDeviceAttributeMultiprocessorCount, dev) != hipSuccess) { fprintf(stderr, "kernel_launch: device query failed\n"); grid = -1; return; }
        if (hipFuncSetAttribute((const void*)trunk_fwd, hipFuncAttributeMaxDynamicSharedMemorySize, LDS_BYTES) != hipSuccess) { fprintf(stderr, "kernel_launch: hipFuncSetAttribute failed\n"); grid = -1; return; }
        if (hipOccupancyMaxActiveBlocksPerMultiprocessor(&per_cu, (const void*)trunk_fwd, NWAVES * 64, LDS_BYTES) != hipSuccess || per_cu < 1)
            fprintf(stderr, "kernel_launch: note: occupancy query reports %d workgroups per CU\n", per_cu);
        (void)hipGetLastError();
        grid = cus;
        if (grid != 256) fprintf(stderr, "kernel_launch: %d CUs; this kernel is built for 256\n", grid);
    }
    if (grid < 0) return;
    if (hipMemsetAsync((char*)d_ws + WS_CTL, 0, CTL_ZERO_BYTES, stream) != hipSuccess) { fprintf(stderr, "kernel_launch: memset failed\n"); return; }
    Args a{};
    a.x = (const float*)d_in[0]; a.c = (const float*)d_in[1]; a.pos = (const int*)d_in[2]; a.ada_w = (const float*)d_in[3]; a.ada_b = (const float*)d_in[4]; a.norm_g = (const float*)d_in[5];
    a.a_win = (const float*)d_in[6]; a.a_qn = (const float*)d_in[7]; a.a_kn = (const float*)d_in[8]; a.a_sink = (const float*)d_in[9]; a.a_wout = (const float*)d_in[10];
    a.p_win = (const float*)d_in[11]; a.p_wg = (const float*)d_in[12]; a.p_scale = (const float*)d_in[13]; a.p_wout = (const float*)d_in[14];
    a.out = (float*)d_out; a.ws = (unsigned char*)d_ws;
#if MK_ONE_LAUNCH
    a.ph_lo = 0; a.ph_hi = N_PHASES;
    hipLaunchKernelGGL(trunk_fwd, dim3(grid), dim3(NWAVES * 64), LDS_BYTES, stream, a);
#else
    for (int ph = 0; ph < N_PHASES; ++ph) { a.ph_lo = ph; a.ph_hi = ph + 1; hipLaunchKernelGGL(trunk_fwd, dim3(grid), dim3(NWAVES * 64), LDS_BYTES, stream, a); }
#endif
}
```
